# Optimizing an MI355X kernel written in HIP

```python
import math
import jax, jax.numpy as jnp
from jax import lax
import numpy as np

D_MODEL = 1024
BATCH = 8
SEQ = 2048
DEPTH = 1
DEC_BATCH = 128
DEC_SEQ = 4
PAST_LEN = 8192
PAGE_SIZE = 128

N_META = 16
D_MIX = D_MODEL
HEAD_DIM = 64
ATTN_WIDTH = D_MIX // 2
N_HEADS = ATTN_WIDTH // HEAD_DIM
N_KV_HEADS = 2
GQA_GROUP = N_HEADS // N_KV_HEADS
KV_WIDTH = N_KV_HEADS * HEAD_DIM
WINDOW = 128
BLOCK = 128
SSM_WIDTH = D_MIX - ATTN_WIDTH
SSM_GROUP = 16
N_SSM_GROUPS = SSM_WIDTH // SSM_GROUP
SSM_STATE = 64
IN_COLS = ATTN_WIDTH + 2 * KV_WIDTH + SSM_WIDTH
D_FF = 2816
CONV_W = 3
EPS = 1e-5
DT_MIN = 1e-3
DT_MAX = 1e-1

kernel_name = "hymba_swa_sink_s5_convffn_step"


def rms_norm(x, g):
    xf = x.astype(jnp.float32)
    y = xf * lax.rsqrt(jnp.mean(xf * xf, axis=-1, keepdims=True) + EPS)
    return (y * g.astype(jnp.float32)).astype(x.dtype)


def sink_softmax(s, sink):
    m = jnp.maximum(jnp.max(s, axis=-1), sink)
    p = jnp.exp(s - m[..., None])
    denom = jnp.sum(p, axis=-1) + jnp.exp(sink - m)
    return p / denom[..., None]


def swa_banded(q, k, v, sinks):
    n, length = q.shape[:2]
    front = (-N_META) % BLOCK
    back = (-(front + length)) % BLOCK
    lp = front + length + back
    nb = lp // BLOCK
    pad = ((0, 0), (front, back), (0, 0), (0, 0))
    qb = jnp.pad(q, pad).reshape(n, nb, BLOCK, N_KV_HEADS, GQA_GROUP, HEAD_DIM)
    kb = jnp.pad(k, pad).reshape(n, nb, BLOCK, N_KV_HEADS, HEAD_DIM)
    vb = jnp.pad(v, pad).reshape(n, nb, BLOCK, N_KV_HEADS, HEAD_DIM)
    zero_blk = jnp.zeros_like(kb[:, :1])
    kk = jnp.concatenate([jnp.concatenate([zero_blk, kb[:, :-1]], axis=1), kb], axis=2)
    vv = jnp.concatenate([jnp.concatenate([zero_blk, vb[:, :-1]], axis=1), vb], axis=2)
    qpos = (jnp.arange(lp) - front).reshape(nb, BLOCK)
    kpos = jnp.concatenate([qpos - BLOCK, qpos], axis=1)
    mask = ((kpos[:, None, :] <= qpos[:, :, None]) & (kpos[:, None, :] > qpos[:, :, None] - WINDOW)
            & (kpos[:, None, :] >= 0) & (kpos[:, None, :] < length))
    scale = HEAD_DIM ** -0.5
    s = jnp.einsum('bnqkgd,bnskd->bnkgqs', qb.astype(jnp.float32), kk.astype(jnp.float32)) * scale
    s = jnp.where(mask[None, :, None, None], s, -jnp.inf)
    sink = sinks.astype(jnp.float32).reshape(N_KV_HEADS, GQA_GROUP)[None, None, :, :, None]
    p = sink_softmax(s, sink)
    o = jnp.einsum('bnkgqs,bnskd->bnqkgd', p, vv.astype(jnp.float32))
    o = o.reshape(n, lp, ATTN_WIDTH)[:, front:front + length]
    return o.astype(q.dtype)


def swa_cached(q, k, v, k_buf, v_buf, sinks):
    n, t = q.shape[:2]
    wb = k_buf.shape[1]
    k_all = jnp.concatenate([k_buf.astype(k.dtype), k], axis=1)
    v_all = jnp.concatenate([v_buf.astype(v.dtype), v], axis=1)
    qpos = PAST_LEN + jnp.arange(t)
    kpos = PAST_LEN - wb + jnp.arange(wb + t)
    mask = (kpos[None, :] <= qpos[:, None]) & (kpos[None, :] > qpos[:, None] - WINDOW)
    qg = q.reshape(n, t, N_KV_HEADS, GQA_GROUP, HEAD_DIM).astype(jnp.float32)
    s = jnp.einsum('btkgd,bskd->bkgts', qg, k_all.astype(jnp.float32)) * (HEAD_DIM ** -0.5)
    s = jnp.where(mask[None, None, None], s, -jnp.inf)
    sink = sinks.astype(jnp.float32).reshape(N_KV_HEADS, GQA_GROUP)[None, :, :, None]
    p = sink_softmax(s, sink)
    o = jnp.einsum('bkgts,bskd->btkgd', p, v_all.astype(jnp.float32)).reshape(n, t, ATTN_WIDTH)
    return o.astype(q.dtype), k_all, v_all


def s5_scan(u, h0, lam_re, lam_im, log_dt, b_re, b_im, c_re, c_im, d_skip):
    f32 = jnp.float32
    n, t, _ = u.shape
    lam = lax.complex(lam_re.astype(f32), lam_im.astype(f32))
    dt = jnp.exp(log_dt.astype(f32))[:, None]
    lam_bar = jnp.exp(lam * dt)
    bmat = lax.complex(b_re.astype(f32), b_im.astype(f32))
    b_bar = ((lam_bar - 1.0) / lam)[..., None] * bmat
    uf = u.astype(f32)
    ug = uf.reshape(n, t, N_SSM_GROUPS, SSM_GROUP).astype(jnp.complex64)
    bu = jnp.einsum('ntgc,gpc->ntgp', ug, b_bar)
    bu = bu.at[:, 0].add(lam_bar[None] * h0)
    a = jnp.broadcast_to(lam_bar, bu.shape)

    def combine(e1, e2):
        a1, b1 = e1
        a2, b2 = e2
        return a2 * a1, a2 * b1 + b2

    _, h = lax.associative_scan(combine, (a, bu), axis=1)
    cmat = lax.complex(c_re.astype(f32), c_im.astype(f32))
    y = jnp.real(jnp.einsum('ntgp,gcp->ntgc', h, cmat)).reshape(n, t, SSM_WIDTH)
    y = y + d_skip.astype(f32) * uf
    return y, h[:, -1]


def conv_ffn(xn, buf, w_gate, w_up, conv_w, conv_b, w_down):
    t = xn.shape[1]
    g = xn @ w_gate
    up = xn @ w_up
    gp = jnp.concatenate([buf.astype(g.dtype), g], axis=1)
    c = conv_b
    for j in range(CONV_W):
        c = c + conv_w[j] * gp[:, j:j + t]
    h = jax.nn.silu(c) * up
    return h @ w_down, gp[:, -(CONV_W - 1):]


def decoder_layer(x, k_buf, v_buf, h0, conv_buf,
                  g_mix, w_in, sinks, lam_re, lam_im, log_dt, b_re, b_im, c_re, c_im, d_skip,
                  w_glu, b_glu, g_attn_out, g_ssm_out, w_o, g_ffn, w_gate, w_up, conv_w, conv_b, w_down):
    n, t, _ = x.shape
    wb = min(WINDOW, PAST_LEN)
    xn = rms_norm(x, g_mix)
    proj = xn @ w_in
    q = proj[..., :ATTN_WIDTH].reshape(n, t, N_HEADS, HEAD_DIM)
    k = proj[..., ATTN_WIDTH:ATTN_WIDTH + KV_WIDTH].reshape(n, t, N_KV_HEADS, HEAD_DIM)
    v = proj[..., ATTN_WIDTH + KV_WIDTH:ATTN_WIDTH + 2 * KV_WIDTH].reshape(n, t, N_KV_HEADS, HEAD_DIM)
    u = proj[..., ATTN_WIDTH + 2 * KV_WIDTH:]
    if k_buf is None:
        attn = swa_banded(q, k, v, sinks)
        k_all, v_all = k, v
    else:
        attn, k_all, v_all = swa_cached(q, k, v, k_buf, v_buf, sinks)
    new_k, new_v = k_all[:, -wb:], v_all[:, -wb:]
    y_ssm, h_last = s5_scan(u, h0, lam_re, lam_im, log_dt, b_re, b_im, c_re, c_im, d_skip)
    g = jax.nn.gelu(y_ssm)
    ssm = (g * jax.nn.sigmoid(g @ w_glu.astype(jnp.float32) + b_glu.astype(jnp.float32))).astype(x.dtype)
    mixed = jnp.concatenate([rms_norm(attn, g_attn_out), rms_norm(ssm, g_ssm_out)], axis=-1) @ w_o
    x = x + mixed
    ffn, new_conv = conv_ffn(rms_norm(x, g_ffn), conv_buf, w_gate, w_up, conv_w, conv_b, w_down)
    x = x + ffn
    return x, new_k, new_v, h_last, new_conv


def setup_inputs(seed: int = 0) -> dict:
    key = jax.random.key(seed)
    ks = iter(jax.random.split(key, 40))
    f32 = jnp.float32
    wb = min(WINDOW, PAST_LEN)
    nrm = lambda shape, s: jax.random.normal(next(ks), shape, f32) * s
    gain = lambda shape: 1.0 + 0.01 * jax.random.normal(next(ks), shape, f32)
    n_idx = jnp.arange(SSM_STATE, dtype=f32)
    inp = {
        "x_prompt": nrm((BATCH, SEQ, D_MODEL), 1.0),
        "x_sample": nrm((DEC_BATCH, DEC_SEQ, D_MODEL), 1.0),
        "cache_k_win": nrm((DEPTH, DEC_BATCH, wb, N_KV_HEADS, HEAD_DIM), 1.0),
        "cache_v_win": nrm((DEPTH, DEC_BATCH, wb, N_KV_HEADS, HEAD_DIM), 1.0),
        "state_ssm_re": nrm((DEPTH, DEC_BATCH, N_SSM_GROUPS, SSM_STATE), 0.1),
        "state_ssm_im": nrm((DEPTH, DEC_BATCH, N_SSM_GROUPS, SSM_STATE), 0.1),
        "state_conv": nrm((DEPTH, DEC_BATCH, CONV_W - 1, D_FF), 1.0),
        "meta_tokens": nrm((N_META, D_MODEL), 1.0),
        "g_mix": gain((DEPTH, D_MODEL)),
        "w_in": nrm((DEPTH, D_MODEL, IN_COLS), D_MODEL ** -0.5),
        "sinks": nrm((DEPTH, N_HEADS), 0.5),
        "lam_re": -0.5 + nrm((DEPTH, N_SSM_GROUPS, SSM_STATE), 0.01),
        "lam_im": math.pi * n_idx + nrm((DEPTH, N_SSM_GROUPS, SSM_STATE), 0.01),
        "log_dt": jax.random.uniform(next(ks), (DEPTH, N_SSM_GROUPS), f32,
                                     math.log(DT_MIN), math.log(DT_MAX)),
        "b_re": nrm((DEPTH, N_SSM_GROUPS, SSM_STATE, SSM_GROUP), (2 * SSM_GROUP) ** -0.5),
        "b_im": nrm((DEPTH, N_SSM_GROUPS, SSM_STATE, SSM_GROUP), (2 * SSM_GROUP) ** -0.5),
        "c_re": nrm((DEPTH, N_SSM_GROUPS, SSM_GROUP, SSM_STATE), (2 * SSM_STATE) ** -0.5),
        "c_im": nrm((DEPTH, N_SSM_GROUPS, SSM_GROUP, SSM_STATE), (2 * SSM_STATE) ** -0.5),
        "d_skip": nrm((DEPTH, SSM_WIDTH), 1.0),
        "w_glu": nrm((DEPTH, SSM_WIDTH, SSM_WIDTH), SSM_WIDTH ** -0.5),
        "b_glu": nrm((DEPTH, SSM_WIDTH), 0.01),
        "g_attn_out": gain((DEPTH, ATTN_WIDTH)),
        "g_ssm_out": gain((DEPTH, SSM_WIDTH)),
        "w_o": nrm((DEPTH, D_MIX, D_MODEL), D_MIX ** -0.5),
        "g_ffn": gain((DEPTH, D_MODEL)),
        "w_gate": nrm((DEPTH, D_MODEL, D_FF), D_MODEL ** -0.5),
        "w_up": nrm((DEPTH, D_MODEL, D_FF), D_MODEL ** -0.5),
        "conv_w": nrm((DEPTH, CONV_W, D_FF), CONV_W ** -0.5),
        "conv_b": nrm((DEPTH, D_FF), 0.01),
        "w_down": nrm((DEPTH, D_FF, D_MODEL), D_FF ** -0.5),
        "g_final": gain((D_MODEL,)),
    }
    return inp


def reference(x_prompt, x_sample, cache_k_win, cache_v_win, state_ssm_re, state_ssm_im, state_conv,
              meta_tokens, g_mix, w_in, sinks, lam_re, lam_im, log_dt, b_re, b_im, c_re, c_im, d_skip,
              w_glu, b_glu, g_attn_out, g_ssm_out, w_o, g_ffn, w_gate, w_up, conv_w, conv_b, w_down,
              g_final):
    f32 = jnp.float32
    bsz = x_prompt.shape[0]
    meta = jnp.broadcast_to(meta_tokens.astype(x_prompt.dtype)[None], (bsz, N_META, D_MODEL))
    xp = jnp.concatenate([meta, x_prompt], axis=1)
    xs = x_sample
    pk, pv, pre, pim, pc = [], [], [], [], []
    sk, sv, sre, sim, sc = [], [], [], [], []
    for l in range(DEPTH):
        weights = (g_mix[l], w_in[l], sinks[l], lam_re[l], lam_im[l], log_dt[l], b_re[l], b_im[l],
                   c_re[l], c_im[l], d_skip[l], w_glu[l], b_glu[l], g_attn_out[l], g_ssm_out[l], w_o[l],
                   g_ffn[l], w_gate[l], w_up[l], conv_w[l], conv_b[l], w_down[l])
        h0_p = jnp.zeros((bsz, N_SSM_GROUPS, SSM_STATE), jnp.complex64)
        conv0_p = jnp.zeros((bsz, CONV_W - 1, D_FF), xp.dtype)
        xp, k_p, v_p, h_p, c_p = decoder_layer(xp, None, None, h0_p, conv0_p, *weights)
        h0_s = lax.complex(state_ssm_re[l].astype(f32), state_ssm_im[l].astype(f32))
        xs, k_s, v_s, h_s, c_s = decoder_layer(xs, cache_k_win[l], cache_v_win[l], h0_s, state_conv[l], *weights)
        pk.append(k_p); pv.append(v_p); pre.append(jnp.real(h_p)); pim.append(jnp.imag(h_p)); pc.append(c_p)
        sk.append(k_s); sv.append(v_s); sre.append(jnp.real(h_s)); sim.append(jnp.imag(h_s)); sc.append(c_s)
    y_prompt = rms_norm(xp, g_final)[:, N_META:]
    y_sample = rms_norm(xs, g_final)
    return (y_prompt, y_sample,
            jnp.stack(pk), jnp.stack(pv), jnp.stack(pre), jnp.stack(pim), jnp.stack(pc),
            jnp.stack(sk), jnp.stack(sv), jnp.stack(sre), jnp.stack(sim), jnp.stack(sc))
```

```cpp
#include <hip/hip_runtime.h>
#include <cstdio>
#include <cstdint>
namespace rf {
constexpr int D = 1024, NB = 8, SEQ = 2048, NMETA = 16, LP = SEQ + NMETA, DB = 128, DS = 4;
constexpr int RP = NB * LP, RS = DB * DS, MT = RP + RS;
constexpr int INC = 1280, AW = 512, KVW = 128, SW = 512, HD = 64, NH = 8, NKV = 2, WIN = 128;
constexpr int NG = 32, SG = 16, SP = 64, FF = 2816;
constexpr float EPS = 1e-5f;

__device__ __forceinline__ const float* xrow(const float* xp, const float* xs, const float* meta, int r) {
    if (r < RP) { const int b = r / LP, p = r % LP; return p < NMETA ? meta + (size_t)p * D : xp + ((size_t)b * SEQ + (p - NMETA)) * D; }
    return xs + (size_t)(r - RP) * D;
}
__device__ __forceinline__ float wsum(float v) {
#pragma unroll
    for (int o = 32; o >= 1; o >>= 1) v += __shfl_xor(v, o);
    return v;
}
__device__ __forceinline__ float wmax(float v) {
#pragma unroll
    for (int o = 32; o >= 1; o >>= 1) v = fmaxf(v, __shfl_xor(v, o));
    return v;
}
__global__ void __launch_bounds__(256) k_rms_x(const float* xp, const float* xs, const float* meta, const float* g, float* out) {
    const int r = blockIdx.x * 4 + (threadIdx.x >> 6), lane = threadIdx.x & 63; if (r >= MT) return;
    const float* x = xrow(xp, xs, meta, r); float v[16]; float s = 0.f;
#pragma unroll
    for (int i = 0; i < 16; ++i) { v[i] = x[lane + 64 * i]; s += v[i] * v[i]; }
    s = wsum(s); const float sc = rsqrtf(s * (1.f / D) + EPS);
#pragma unroll
    for (int i = 0; i < 16; ++i) out[(size_t)r * D + lane + 64 * i] = v[i] * sc * g[lane + 64 * i];
}
__global__ void __launch_bounds__(256) k_rms(const float* in, int ldi, const float* g, float* out, int ldo, int n, int rows) {
    const int r = blockIdx.x * 4 + (threadIdx.x >> 6), lane = threadIdx.x & 63; if (r >= rows) return;
    const float* x = in + (size_t)r * ldi; float s = 0.f;
    for (int i = lane; i < n; i += 64) s += x[i] * x[i];
    s = wsum(s); const float sc = rsqrtf(s / (float)n + EPS);
    for (int i = lane; i < n; i += 64) out[(size_t)r * ldo + i] = x[i] * sc * g[i];
}
__global__ void __launch_bounds__(256) k_gemm(const float* __restrict__ A, int lda, const float* __restrict__ W, int ldw, float* __restrict__ C, int ldc, int M, int N, int K) {
    __shared__ float As[16][68]; __shared__ float Ws[16][68];
    const int t = threadIdx.x, tx = t & 15, ty = t >> 4, m0 = blockIdx.y * 64, n0 = blockIdx.x * 64;
    float acc[4][4];
#pragma unroll
    for (int i = 0; i < 4; ++i)
#pragma unroll
        for (int j = 0; j < 4; ++j) acc[i][j] = 0.f;
    const int ar = t >> 2, ac = (t & 3) * 4, wr = t >> 4, wc = (t & 15) * 4;
    for (int k0 = 0; k0 < K; k0 += 16) {
        float4 av = make_float4(0.f, 0.f, 0.f, 0.f);
        if (m0 + ar < M) av = *(const float4*)(A + (size_t)(m0 + ar) * lda + k0 + ac);
        const float4 wv = *(const float4*)(W + (size_t)(k0 + wr) * ldw + n0 + wc);
        As[ac + 0][ar] = av.x; As[ac + 1][ar] = av.y; As[ac + 2][ar] = av.z; As[ac + 3][ar] = av.w;
        *(float4*)&Ws[wr][wc] = wv;
        __syncthreads();
#pragma unroll
        for (int kk = 0; kk < 16; ++kk) {
            const float4 a = *(const float4*)&As[kk][ty * 4]; const float4 b = *(const float4*)&Ws[kk][tx * 4];
            const float aa[4] = {a.x, a.y, a.z, a.w}, bb[4] = {b.x, b.y, b.z, b.w};
#pragma unroll
            for (int i = 0; i < 4; ++i)
#pragma unroll
                for (int j = 0; j < 4; ++j) acc[i][j] += aa[i] * bb[j];
        }
        __syncthreads();
    }
#pragma unroll
    for (int i = 0; i < 4; ++i) { const int r = m0 + ty * 4 + i; if (r < M) *(float4*)(C + (size_t)r * ldc + n0 + tx * 4) = make_float4(acc[i][0], acc[i][1], acc[i][2], acc[i][3]); }
}
__global__ void __launch_bounds__(256) k_attn_prompt(const float* __restrict__ proj, const float* __restrict__ sinks, float* __restrict__ att) {
    const int task = blockIdx.x * 4 + (threadIdx.x >> 6), lane = threadIdx.x & 63; if (task >= RP * NH) return;
    const int r = task / NH, h = task % NH, kvh = h / 4, b = r / LP, p = r % LP;
    const float qd = proj[(size_t)r * INC + h * HD + lane];
    const int lo = p - (WIN - 1) > 0 ? p - (WIN - 1) : 0, nk = p - lo + 1;
    float s[2];
#pragma unroll
    for (int half = 0; half < 2; ++half) {
        const int ki = half * 64 + lane; float a = 0.f;
        const int kp = ki < nk ? lo + ki : p;
        const float* kr = proj + ((size_t)(b * LP + kp)) * INC + AW + kvh * HD;
#pragma unroll 8
        for (int d = 0; d < HD; ++d) a += __shfl(qd, d) * kr[d];
        s[half] = ki < nk ? a * 0.125f : -INFINITY;
    }
    const float sink = sinks[h];
    const float m = fmaxf(wmax(fmaxf(s[0], s[1])), sink);
    const float p0 = __expf(s[0] - m), p1 = __expf(s[1] - m);
    const float den = wsum(p0 + p1) + __expf(sink - m);
    float o = 0.f;
    for (int ki = 0; ki < nk; ++ki) {
        const float pk = ki < 64 ? __shfl(p0, ki) : __shfl(p1, ki - 64);
        o += pk * proj[((size_t)(b * LP + lo + ki)) * INC + AW + KVW + kvh * HD + lane];
    }
    att[(size_t)r * AW + h * HD + lane] = o / den;
}
__global__ void __launch_bounds__(256) k_attn_sample(const float* __restrict__ proj, const float* __restrict__ ck, const float* __restrict__ cv, const float* __restrict__ sinks, float* __restrict__ att) {
    const int task = blockIdx.x * 4 + (threadIdx.x >> 6), lane = threadIdx.x & 63; if (task >= RS * NH) return;
    const int rs = task / NH, h = task % NH, kvh = h / 4, n = rs / DS, t = rs % DS, r = RP + rs;
    const float qd = proj[(size_t)r * INC + h * HD + lane];
    const int ncache = WIN - 1 - t;
    float s[2];
#pragma unroll
    for (int half = 0; half < 2; ++half) {
        const int ki = half * 64 + lane;
        const float* kr = ki < ncache ? ck + (((size_t)n * WIN + (t + 1 + ki)) * NKV + kvh) * HD : proj + ((size_t)(RP + n * DS + (ki - ncache))) * INC + AW + kvh * HD;
        float a = 0.f;
#pragma unroll 8
        for (int d = 0; d < HD; ++d) a += __shfl(qd, d) * kr[d];
        s[half] = a * 0.125f;
    }
    const float sink = sinks[h];
    const float m = fmaxf(wmax(fmaxf(s[0], s[1])), sink);
    const float p0 = __expf(s[0] - m), p1 = __expf(s[1] - m);
    const float den = wsum(p0 + p1) + __expf(sink - m);
    float o = 0.f;
    for (int ki = 0; ki < WIN; ++ki) {
        const float pk = ki < 64 ? __shfl(p0, ki) : __shfl(p1, ki - 64);
        const float* vr = ki < ncache ? cv + (((size_t)n * WIN + (t + 1 + ki)) * NKV + kvh) * HD : proj + ((size_t)(RP + n * DS + (ki - ncache))) * INC + AW + KVW + kvh * HD;
        o += pk * vr[lane];
    }
    att[(size_t)r * AW + h * HD + lane] = o / den;
}
__global__ void __launch_bounds__(64) k_ssm(const float* __restrict__ proj, const float* __restrict__ lam_re, const float* __restrict__ lam_im, const float* __restrict__ log_dt,
                                            const float* __restrict__ b_re, const float* __restrict__ b_im, const float* __restrict__ c_re, const float* __restrict__ c_im, const float* __restrict__ d_skip,
                                            const float* __restrict__ st_re, const float* __restrict__ st_im, float* __restrict__ ys, float* __restrict__ p_re, float* __restrict__ p_im, float* __restrict__ s_re, float* __restrict__ s_im) {
    const int seq = blockIdx.x / NG, g = blockIdx.x % NG, p = threadIdx.x;
    const bool prompt = seq < NB; const int n = seq - NB, T = prompt ? LP : DS, r0 = prompt ? seq * LP : RP + n * DS;
    const double lr = lam_re[g * SP + p], li = lam_im[g * SP + p], dt = exp((double)log_dt[g]);
    const double er = exp(lr * dt), lbr = er * cos(li * dt), lbi = er * sin(li * dt);
    const double nr = lbr - 1.0, ni = lbi, dn = lr * lr + li * li; const double fr = (nr * lr + ni * li) / dn, fi = (ni * lr - nr * li) / dn;
    float bbr[SG], bbi[SG], cr[SG], ci[SG];
#pragma unroll
    for (int c = 0; c < SG; ++c) { const double br = b_re[(g * SP + p) * SG + c], bi = b_im[(g * SP + p) * SG + c]; bbr[c] = (float)(fr * br - fi * bi); bbi[c] = (float)(fr * bi + fi * br);
        cr[c] = c_re[(g * SG + c) * SP + p]; ci[c] = c_im[(g * SG + c) * SP + p]; }
    const float ar = (float)lbr, ai = (float)lbi;
    float hr = prompt ? 0.f : st_re[((size_t)n * NG + g) * SP + p], hi = prompt ? 0.f : st_im[((size_t)n * NG + g) * SP + p];
    for (int t = 0; t < T; ++t) {
        const float* u = proj + (size_t)(r0 + t) * INC + AW + 2 * KVW + g * SG;
        float br = 0.f, bi = 0.f;
#pragma unroll
        for (int c = 0; c < SG; ++c) { const float uc = u[c]; br += bbr[c] * uc; bi += bbi[c] * uc; }
        const float nhr = ar * hr - ai * hi + br, nhi = ar * hi + ai * hr + bi; hr = nhr; hi = nhi;
        float myv = 0.f;
#pragma unroll
        for (int c = 0; c < SG; ++c) { const float v = wsum(cr[c] * hr - ci[c] * hi); if (p == c) myv = v; }
        if (p < SG) ys[(size_t)(r0 + t) * SW + g * SG + p] = myv + d_skip[g * SG + p] * u[p];
    }
    if (prompt) { p_re[((size_t)seq * NG + g) * SP + p] = hr; p_im[((size_t)seq * NG + g) * SP + p] = hi; }
    else { s_re[((size_t)n * NG + g) * SP + p] = hr; s_im[((size_t)n * NG + g) * SP + p] = hi; }
}
__device__ __forceinline__ float gelu_tanh(float x) { const float k = 0.7978845608028654f; const float in = k * (x + 0.044715f * x * x * x); return 0.5f * x * (1.f + tanhf(in)); }
__global__ void k_gelu(float* y, size_t n) { const size_t i = (size_t)blockIdx.x * blockDim.x + threadIdx.x; if (i < n) y[i] = gelu_tanh(y[i]); }
__global__ void k_glu(const float* g, float* z, const float* b, size_t n) { const size_t i = (size_t)blockIdx.x * blockDim.x + threadIdx.x; if (i < n) { const float zz = z[i] + b[i % SW]; z[i] = g[i] / (1.f + __expf(-zz)); } }
__global__ void k_res(const float* xp, const float* xs, const float* meta, float* mix) {
    const int r = blockIdx.x; const float* x = xrow(xp, xs, meta, r);
    for (int i = threadIdx.x; i < D; i += blockDim.x) mix[(size_t)r * D + i] += x[i];
}
__global__ void k_conv(float* gate_, const float* up_, const float* buf_, const float* cw, const float* cb, float* cout_, int T) {
    const int f = blockIdx.x * blockDim.x + threadIdx.x; if (f >= FF) return;
    const int sq = blockIdx.y; float* gate = gate_ + (size_t)sq * T * FF; const float* up = up_ + (size_t)sq * T * FF; const float* buf = buf_ ? buf_ + (size_t)sq * 2 * FF : nullptr; float* cout = cout_ + (size_t)sq * 2 * FF;
    const float w0 = cw[f], w1 = cw[FF + f], w2 = cw[2 * FF + f], bb = cb[f];
    float g2 = buf ? buf[f] : 0.f, g1 = buf ? buf[FF + f] : 0.f;
    for (int t = 0; t < T; ++t) { const float g0 = gate[(size_t)t * FF + f]; const float c = bb + w0 * g2 + w1 * g1 + w2 * g0;
        gate[(size_t)t * FF + f] = c / (1.f + __expf(-c)) * up[(size_t)t * FF + f]; g2 = g1; g1 = g0; }
    cout[f] = g2; cout[FF + f] = g1;
}
__global__ void __launch_bounds__(256) k_final(const float* x1, const float* ff, const float* g, float* yp, float* ysmp, int r0, int rows) {
    const int lr = blockIdx.x * 4 + (threadIdx.x >> 6), lane = threadIdx.x & 63; if (lr >= rows) return;
    const int r = r0 + lr; float* o;
    if (r < RP) { const int b = r / LP, p = r % LP; if (p < NMETA) return; o = yp + ((size_t)b * SEQ + (p - NMETA)) * D; } else o = ysmp + (size_t)(r - RP) * D;
    float v[16]; float s = 0.f;
#pragma unroll
    for (int i = 0; i < 16; ++i) { v[i] = x1[(size_t)r * D + lane + 64 * i] + ff[(size_t)lr * D + lane + 64 * i]; s += v[i] * v[i]; }
    s = wsum(s); const float sc = rsqrtf(s * (1.f / D) + EPS);
#pragma unroll
    for (int i = 0; i < 16; ++i) o[lane + 64 * i] = v[i] * sc * g[lane + 64 * i];
}
__global__ void k_cache(const float* proj, const float* ck, const float* cv, float* pk, float* pv, float* sk, float* sv) {
    const int i = blockIdx.x * blockDim.x + threadIdx.x;
    if (i < NB * WIN * KVW) { const int b = i / (WIN * KVW), w = (i / KVW) % WIN, c = i % KVW; const size_t r = (size_t)b * LP + (LP - WIN) + w;
        pk[i] = proj[r * INC + AW + c]; pv[i] = proj[r * INC + AW + KVW + c]; }
    if (i < DB * WIN * KVW) { const int n = i / (WIN * KVW), w = (i / KVW) % WIN, c = i % KVW;
        if (w < WIN - DS) { sk[i] = ck[((size_t)n * WIN + w + DS) * KVW + c]; sv[i] = cv[((size_t)n * WIN + w + DS) * KVW + c]; }
        else { const size_t r = (size_t)RP + n * DS + (w - (WIN - DS)); sk[i] = proj[r * INC + AW + c]; sv[i] = proj[r * INC + AW + KVW + c]; } }
}
struct Out { float *yp, *ys, *pk, *pv, *pre, *pim, *pc, *sk, *sv, *sre, *sim, *sc; };
inline Out carve(float* o) { Out r; r.yp = o; o += (size_t)NB * SEQ * D; r.ys = o; o += (size_t)RS * D; r.pk = o; o += NB * WIN * KVW; r.pv = o; o += NB * WIN * KVW; r.pre = o; o += NB * NG * SP; r.pim = o; o += NB * NG * SP;
    r.pc = o; o += NB * 2 * FF; r.sk = o; o += DB * WIN * KVW; r.sv = o; o += DB * WIN * KVW; r.sre = o; o += DB * NG * SP; r.sim = o; o += DB * NG * SP; r.sc = o; return r; }

inline void forward(void* const* d_in, float* d_out, unsigned char* ws, hipStream_t st) {
    const float* xp = (const float*)d_in[0]; const float* xs = (const float*)d_in[1]; const float* ck = (const float*)d_in[2]; const float* cv = (const float*)d_in[3];
    const float* sre = (const float*)d_in[4]; const float* sim = (const float*)d_in[5]; const float* sconv = (const float*)d_in[6]; const float* meta = (const float*)d_in[7];
    const float* g_mix = (const float*)d_in[8]; const float* w_in = (const float*)d_in[9]; const float* sinks = (const float*)d_in[10];
    const float* lam_re = (const float*)d_in[11]; const float* lam_im = (const float*)d_in[12]; const float* log_dt = (const float*)d_in[13];
    const float* b_re = (const float*)d_in[14]; const float* b_im = (const float*)d_in[15]; const float* c_re = (const float*)d_in[16]; const float* c_im = (const float*)d_in[17];
    const float* d_skip = (const float*)d_in[18]; const float* w_glu = (const float*)d_in[19]; const float* b_glu = (const float*)d_in[20];
    const float* g_a = (const float*)d_in[21]; const float* g_s = (const float*)d_in[22]; const float* w_o = (const float*)d_in[23]; const float* g_ffn = (const float*)d_in[24];
    const float* w_gate = (const float*)d_in[25]; const float* w_up = (const float*)d_in[26]; const float* conv_w = (const float*)d_in[27]; const float* conv_b = (const float*)d_in[28];
    const float* w_down = (const float*)d_in[29]; const float* g_final = (const float*)d_in[30];
    Out O = carve(d_out);
    float* A = (float*)ws;
    float* B = A + (size_t)MT * D;
    float* C = B + (size_t)MT * INC;
    float* Dd = C + (size_t)MT * AW;
    float* E = Dd + (size_t)MT * SW;
    k_rms_x<<<(MT + 3) / 4, 256, 0, st>>>(xp, xs, meta, g_mix, A);
    k_gemm<<<dim3(INC / 64, (MT + 63) / 64), 256, 0, st>>>(A, D, w_in, INC, B, INC, MT, INC, D);
    k_cache<<<(DB * WIN * KVW + 255) / 256, 256, 0, st>>>(B, ck, cv, O.pk, O.pv, O.sk, O.sv);
    k_attn_prompt<<<(RP * NH + 3) / 4, 256, 0, st>>>(B, sinks, C);
    k_attn_sample<<<(RS * NH + 3) / 4, 256, 0, st>>>(B, ck, cv, sinks, C);
    k_ssm<<<(NB + DB) * NG, 64, 0, st>>>(B, lam_re, lam_im, log_dt, b_re, b_im, c_re, c_im, d_skip, sre, sim, Dd, O.pre, O.pim, O.sre, O.sim);
    { const size_t n = (size_t)MT * SW; k_gelu<<<(unsigned)((n + 255) / 256), 256, 0, st>>>(Dd, n);
      k_gemm<<<dim3(SW / 64, (MT + 63) / 64), 256, 0, st>>>(Dd, SW, w_glu, SW, E, SW, MT, SW, SW);
      k_glu<<<(unsigned)((n + 255) / 256), 256, 0, st>>>(Dd, E, b_glu, n); }
    k_rms<<<(MT + 3) / 4, 256, 0, st>>>(C, AW, g_a, A, D, AW, MT);
    k_rms<<<(MT + 3) / 4, 256, 0, st>>>(E, SW, g_s, A + AW, D, SW, MT);
    k_gemm<<<dim3(D / 64, (MT + 63) / 64), 256, 0, st>>>(A, D, w_o, D, B, D, MT, D, D);
    k_res<<<MT, 256, 0, st>>>(xp, xs, meta, B);
    k_rms<<<(MT + 3) / 4, 256, 0, st>>>(B, D, g_ffn, A, D, D, MT);
    float* GT = C; float* UP = GT + (size_t)LP * FF; float* FO = UP + (size_t)LP * FF;
    for (int b = 0; b < NB; ++b) {
        const int r0 = b * LP;
        k_gemm<<<dim3(FF / 64, (LP + 63) / 64), 256, 0, st>>>(A + (size_t)r0 * D, D, w_gate, FF, GT, FF, LP, FF, D);
        k_gemm<<<dim3(FF / 64, (LP + 63) / 64), 256, 0, st>>>(A + (size_t)r0 * D, D, w_up, FF, UP, FF, LP, FF, D);
        k_conv<<<dim3((FF + 255) / 256, 1), 256, 0, st>>>(GT, UP, nullptr, conv_w, conv_b, O.pc + (size_t)b * 2 * FF, LP);
        k_gemm<<<dim3(D / 64, (LP + 63) / 64), 256, 0, st>>>(GT, FF, w_down, D, FO, D, LP, D, FF);
        k_final<<<(LP + 3) / 4, 256, 0, st>>>(B, FO, g_final, O.yp, O.ys, r0, LP);
    }
    {
        k_gemm<<<dim3(FF / 64, (RS + 63) / 64), 256, 0, st>>>(A + (size_t)RP * D, D, w_gate, FF, GT, FF, RS, FF, D);
        k_gemm<<<dim3(FF / 64, (RS + 63) / 64), 256, 0, st>>>(A + (size_t)RP * D, D, w_up, FF, UP, FF, RS, FF, D);
        k_conv<<<dim3((FF + 255) / 256, DB), 256, 0, st>>>(GT, UP, sconv, conv_w, conv_b, O.sc, DS);
        k_gemm<<<dim3(D / 64, (RS + 63) / 64), 256, 0, st>>>(GT, FF, w_down, D, FO, D, RS, D, FF);
        k_final<<<(RS + 3) / 4, 256, 0, st>>>(B, FO, g_final, O.yp, O.ys, RP, RS);
    }
}
}

extern "C" void kernel_launch(void* const* d_in, const int* in_sizes, int n_in, void* d_out, int out_size, void* d_ws, size_t ws_size, hipStream_t stream) {
    (void)in_sizes; (void)n_in; (void)out_size; (void)ws_size;
    rf::forward(d_in, (float*)d_out, (unsigned char*)d_ws, stream);
}
```

```cpp
#include <hip/hip_runtime.h>
#include <cstdio>
#include <cstdint>
#include <cmath>
#define MK_DEBUG (-1)
constexpr int D_MODEL = 1024, NBATCH = 8, SEQ = 2048, NMETA = 16, DBATCH = 128, DSEQ = 4, NHEAD = 8, NKVH = 2, HDIM = 64, WIN = 128;
constexpr int AW = 512, KVW = 128, SW = 512, INC = 1280, NG = 32, SG = 16, SP = 64, FF = 2816;
constexpr float EPS = 1e-5f;
constexpr int R_SMP = NBATCH * SEQ, R_META = R_SMP + DBATCH * DSEQ, R_END = R_META + NMETA, MROWS = 67 * 256;
constexpr float QSCALE = 0.125f * 1.4426950408889634f;
constexpr int TCH = 32, NCH = 65;

constexpr size_t KiB = 1024, MiB = 1u << 20;
constexpr size_t WS_CTL = 0, CTL_ZERO_BYTES = 1 * MiB;
constexpr int CW_TMO = 0, CW_CODE = 1, CW_BAR = 4096;
constexpr size_t CTL_SSQ_A = 64 * KiB, CTL_SSQ_S = CTL_SSQ_A + MROWS * 4, CTL_SSQ_X1 = CTL_SSQ_S + MROWS * 4, CTL_SSQ_X2 = CTL_SSQ_X1 + MROWS * 4;
static_assert(CTL_SSQ_X2 + MROWS * 4 <= CTL_ZERO_BYTES, "ctl");
constexpr size_t WS_WIN = 1 * MiB;
constexpr size_t WS_WGLU = WS_WIN + (size_t)INC * D_MODEL * 2;
constexpr size_t WS_WO = WS_WGLU + (size_t)SW * SW * 2;
constexpr size_t WS_WGU = WS_WO + (size_t)D_MODEL * D_MODEL * 2;
constexpr size_t WS_WD = WS_WGU + (size_t)2 * FF * D_MODEL * 2;
constexpr size_t WS_W1 = WS_WD + (size_t)D_MODEL * FF * 2;
constexpr size_t WS_W2 = WS_W1 + (size_t)NG * 128 * 512 * 2;
constexpr size_t WS_KC = WS_W2 + (size_t)NG * 512 * 128 * 2;
constexpr size_t WS_LAMT = WS_KC + (size_t)NG * 33 * 256 * 2;
constexpr size_t WS_LB = WS_LAMT + (size_t)NG * SP * 8;
constexpr size_t WS_BB = WS_LB + (size_t)NG * SP * 8;
constexpr size_t WS_XN = (WS_BB + (size_t)NG * SP * SG * 8 + 4095) / 4096 * 4096;
constexpr size_t WS_QB = WS_XN + (size_t)MROWS * D_MODEL * 2;
constexpr size_t WS_KB = WS_QB + (size_t)MROWS * AW * 2;
constexpr size_t WS_VB = WS_KB + (size_t)MROWS * KVW * 2;
constexpr size_t WS_UG = WS_VB + (size_t)MROWS * KVW * 2;
constexpr size_t WS_AO = WS_UG + (size_t)MROWS * SW * 2;
constexpr size_t WS_GG = WS_AO + (size_t)MROWS * D_MODEL * 2;
constexpr size_t WS_HB = WS_QB;
constexpr size_t WS_AFTER = WS_GG + (size_t)MROWS * SW * 2;
static_assert(WS_HB + (size_t)MROWS * FF * 2 <= WS_AFTER, "h overlay");
constexpr size_t WS_X1M = WS_AFTER;
constexpr size_t WS_END = WS_X1M + (size_t)256 * D_MODEL * 4;
constexpr size_t WS_CVG = WS_WIN;
constexpr size_t WS_METAG = WS_CVG + (size_t)67 * 4 * FF * 4;
constexpr size_t WS_CV0 = WS_W1;
static_assert(WS_METAG + 2 * FF * 4 <= WS_WGU && WS_CV0 + (size_t)67 * 8 * FF * 4 <= WS_XN, "side buffers over dead weights");
constexpr size_t GS_BYTES = (size_t)MROWS * 32;

constexpr int RING_OFF = 0, RING_BYTES = 131072;
constexpr int LDSCTL_OFF = 155648 - 512, MISC_OFF = LDSCTL_OFF + 320;
constexpr int LDS_BYTES = 155648;
constexpr int NWAVES = 8;
namespace pg8 {
#define PG8_LAS __attribute__((address_space(3)))
typedef unsigned short bf16_t;
typedef short bf16x8 __attribute__((ext_vector_type(8)));
typedef float f32x4 __attribute__((ext_vector_type(4)));
typedef float f32x2 __attribute__((ext_vector_type(2)));
typedef unsigned u32x4 __attribute__((ext_vector_type(4)));
typedef unsigned u32x2 __attribute__((ext_vector_type(2)));
constexpr int BM = 256, BK = 64, HALF = 128, HTB = HALF * BK * 2  , STAGE_BYTES = 8 * HTB, NXCD = 8, WGM = 8;

__host__ __device__ __forceinline__ int lds_byte(int r, int c) { const int st = (r >> 4) * 2 + (c >> 5), rr = r & 15, cc = c & 31, ob = rr * 64 + cc * 2; return st * 1024 + (ob ^ (((ob >> 9) & 1) << 5)); }
__host__ __device__ __forceinline__ void stage_rc(int b, int& R, int& C) { const int st = b / 1024, sb = b % 1024, swz = sb ^ (((sb >> 9) & 1) << 5); R = (st >> 1) * 16 + swz / 64; C = (st & 1) * 32 + (swz % 64) / 2; }
__host__ __device__ __forceinline__ int perm32(int rho) { const int n = rho >> 4, i = rho & 15; return 8 * (i >> 2) + 4 * n + (i & 3); }

struct Unit { int pm, pn; };
struct Gemm { const bf16_t* A; const bf16_t* Bt; int M, N, K, lda; size_t a_gs; int a_il; };

struct StaticOrder {
    int nM, nN, nwg, G, c;
    __host__ __device__ void init(int M, int N, int G_, int c_) { nM = M / BM; nN = N / BM; nwg = nM * nN; G = G_; c = c_; }
    __host__ __device__ bool next(int i, Unit& u) const {
        const long L = (long)i * G + c; if (L >= nwg) return false;
        int wgid = (int)L; { const int q = nwg / NXCD, r = nwg % NXCD, xcd = wgid % NXCD, off = wgid / NXCD; wgid = (xcd < r ? xcd * (q + 1) : r * (q + 1) + (xcd - r) * q) + off; }
        const int nig = WGM * nN, gid = wgid / nig, fm = gid * WGM, gsz = (nM - fm) < WGM ? (nM - fm) : WGM;
        u.pm = fm + ((wgid % nig) % gsz); u.pn = (wgid % nig) / gsz; return true;
    }
    __device__ __forceinline__ void a_ready(const Unit&) const {}
    __device__ __forceinline__ void done(const Unit&) const {}
};
__device__ __forceinline__ unsigned cvt_pk_bf16(float lo, float hi) { unsigned r; asm volatile("v_cvt_pk_bf16_f32 %0, %1, %2" : "=v"(r) : "v"(lo), "v"(hi)); return r; }
template <class Epi, class Sched, bool ALIGN_EPI = false, bool SP2 = false>
__device__ __forceinline__ void gemm_phase(PG8_LAS unsigned char* lds, const Gemm g, const Sched& S, const Epi& E) {
    const int tid = threadIdx.x, wid = __builtin_amdgcn_readfirstlane(tid >> 6), lane = tid & 63, wr = wid >> 2, wc = wid & 3, fr = lane & 15, fq = lane >> 4;
    const int K = g.K, nt = K / BK;
    unsigned voffA[2], voffB[2];
#pragma unroll
    for (int i = 0; i < 2; ++i) { int R, C; stage_rc(tid * 16 + i * 8192, R, C); const int Rb = Epi::PERM ? ((R & ~31) + perm32(R & 31)) : R;
        const int Ra = g.a_il ? ((R >> 6) * 128 + (R & 63)) : R;
        voffA[i] = g.a_gs ? (unsigned)((size_t)(C >> 4) * g.a_gs + (size_t)Ra * 32 + (C & 15) * 2) : (unsigned)(Ra * g.lda + C) * 2u; voffB[i] = (unsigned)(Rb * K + C) * 2u; }
    const size_t kstepA = g.a_gs ? 4 * g.a_gs : (size_t)(BK * 2), hstepA = (g.a_gs ? (size_t)32 : (size_t)g.lda * 2) * (g.a_il ? 64 : HALF), tstepA = (g.a_gs ? (size_t)32 : (size_t)g.lda * 2) * BM;
    const size_t kstepB = (size_t)(BK * 2), hstepB = (size_t)HALF * K * 2, tstepB = 2 * hstepB;
    const unsigned ldsw = (unsigned)wid * 1024u;
    const int aoff = lds_byte(wr * 64 + fr, fq * 8), boff = lds_byte(wc * 32 + fr, fq * 8);
#define PG8_SA(b, h) (((b) * 2 + (h)) * HTB)
#define PG8_SB(b, h) ((4 + (b) * 2 + (h)) * HTB)
#define PG8_STAGE(bufoff, gbase, voff) do { _Pragma("unroll") for (int _i = 0; _i < 2; ++_i) \
        __builtin_amdgcn_global_load_lds((const unsigned*)((const char*)(gbase) + (voff)[_i]), (PG8_LAS unsigned*)(lds + (bufoff) + ldsw + _i * 8192), 16, 0, 0); } while (0)
#define PG8_LDA(dst, b, h) do { _Pragma("unroll") for (int m = 0; m < 4; ++m) _Pragma("unroll") for (int k = 0; k < 2; ++k) dst[m][k] = *(const PG8_LAS bf16x8*)(lds + PG8_SA(b, h) + aoff + m * 2048 + k * 1024); } while (0)
#define PG8_LDB(dst, b, h) do { _Pragma("unroll") for (int n = 0; n < 2; ++n) _Pragma("unroll") for (int k = 0; k < 2; ++k) dst[n][k] = *(const PG8_LAS bf16x8*)(lds + PG8_SB(b, h) + boff + n * 2048 + k * 1024); } while (0)
#define PG8_MMA(ai, bj, At, Bt) do { __builtin_amdgcn_s_setprio(1); _Pragma("unroll") for (int m = 0; m < 4; ++m) _Pragma("unroll") for (int n = 0; n < 2; ++n) _Pragma("unroll") for (int k = 0; k < 2; ++k) \
        acc[ai][bj][m][n] = __builtin_amdgcn_mfma_f32_16x16x32_bf16(Bt[n][k], At[m][k], acc[ai][bj][m][n], 0, 0, 0); __builtin_amdgcn_s_setprio(0); } while (0)
#define PG8_WAIT_V(n) asm volatile("s_waitcnt vmcnt(" #n ")" ::: "memory")
#define PG8_WAIT_L(n) asm volatile("s_waitcnt lgkmcnt(" #n ")" ::: "memory")
#define PG8_BAR __builtin_amdgcn_s_barrier()
#define PG8_SCHED __builtin_amdgcn_sched_barrier(0)
    Unit cur, nxt; int ui = 0;
    if (!S.next(0, cur)) return;
    f32x4 acc[2][2][4][2];
#pragma unroll
    for (int a = 0; a < 2; ++a)
#pragma unroll
        for (int b = 0; b < 2; ++b)
#pragma unroll
            for (int m = 0; m < 4; ++m)
#pragma unroll
                for (int n = 0; n < 2; ++n) acc[a][b][m][n] = (f32x4){0.f, 0.f, 0.f, 0.f};
    bf16x8 At[4][2], B0[2][2], B1[2][2];
    const char* cA = (const char*)g.A + (size_t)cur.pm * tstepA; const char* cB = (const char*)g.Bt + (size_t)cur.pn * tstepB;
    S.a_ready(cur);
    if constexpr (SP2) {
        PG8_STAGE(PG8_SB(0, 0), cB, voffB); PG8_STAGE(PG8_SB(0, 1), cB + hstepB, voffB); PG8_STAGE(PG8_SA(0, 0), cA, voffA); PG8_STAGE(PG8_SA(0, 1), cA + hstepA, voffA);
        if (wr == 1) PG8_BAR;
        PG8_WAIT_V(2); PG8_BAR;
        PG8_STAGE(PG8_SB(1, 0), cB + kstepB, voffB); PG8_STAGE(PG8_SA(1, 0), cA + kstepA, voffA); PG8_STAGE(PG8_SB(1, 1), cB + hstepB + kstepB, voffB);
        PG8_WAIT_V(6); PG8_BAR;
    } else {
        PG8_STAGE(PG8_SB(0, 0), cB, voffB); PG8_STAGE(PG8_SA(0, 0), cA, voffA); PG8_STAGE(PG8_SB(0, 1), cB + hstepB, voffB); PG8_STAGE(PG8_SA(0, 1), cA + hstepA, voffA);
        if (wr == 1) PG8_BAR;
        PG8_WAIT_V(4); PG8_BAR;
        PG8_STAGE(PG8_SB(1, 0), cB + kstepB, voffB); PG8_STAGE(PG8_SA(1, 0), cA + kstepA, voffA); PG8_STAGE(PG8_SB(1, 1), cB + hstepB + kstepB, voffB);
        PG8_WAIT_V(6); PG8_BAR;
    }
    for (;;) {
        const bool has_next = S.next(ui + 1, nxt);
        const char* nA = has_next ? (const char*)g.A + (size_t)nxt.pm * tstepA : cA; const char* nB = has_next ? (const char*)g.Bt + (size_t)nxt.pn * tstepB : cB;
        for (int t = 0; t < nt; t += 2) {
            const bool last = (t == nt - 2);
            const char* a1 = cA + (size_t)(t + 1) * kstepA;
            const char* a2 = last ? nA : cA + (size_t)(t + 2) * kstepA; const char* b2 = last ? nB : cB + (size_t)(t + 2) * kstepB;
            const char* a3 = a2 + kstepA; const char* b3 = b2 + kstepB;
            if (last && has_next) S.a_ready(nxt);
            if constexpr (Epi::MID) { if (t == (nt >> 1)) E.mid(acc, cur, wr, wc, fr, fq); }
            if constexpr (SP2) {
            PG8_LDB(B0, 0, 0); PG8_LDB(B1, 0, 1); PG8_SCHED; PG8_LDA(At, 0, 0); PG8_STAGE(PG8_SA(1, 1), a1 + hstepA, voffA);
            PG8_WAIT_V(8); PG8_WAIT_L(0); PG8_BAR; PG8_MMA(0, 0, At, B0); PG8_MMA(0, 1, At, B1); PG8_BAR; PG8_SCHED;
            PG8_LDA(At, 0, 1); PG8_STAGE(PG8_SB(0, 0), b2, voffB); PG8_STAGE(PG8_SB(0, 1), b2 + hstepB, voffB); PG8_STAGE(PG8_SA(0, 0), a2, voffA);
            PG8_WAIT_V(8); PG8_WAIT_L(0); PG8_BAR; PG8_MMA(1, 0, At, B0); PG8_MMA(1, 1, At, B1); PG8_BAR; PG8_SCHED;
            PG8_LDB(B0, 1, 0); PG8_LDB(B1, 1, 1); PG8_SCHED; PG8_LDA(At, 1, 0); PG8_STAGE(PG8_SA(0, 1), a2 + hstepA, voffA);
            PG8_WAIT_V(8); PG8_WAIT_L(0); PG8_BAR; PG8_MMA(0, 0, At, B0); PG8_MMA(0, 1, At, B1); PG8_BAR; PG8_SCHED;
            PG8_LDA(At, 1, 1); PG8_STAGE(PG8_SB(1, 0), b3, voffB); PG8_STAGE(PG8_SB(1, 1), b3 + hstepB, voffB); PG8_STAGE(PG8_SA(1, 0), a3, voffA);
            PG8_WAIT_V(8); PG8_WAIT_L(0); PG8_BAR; PG8_MMA(1, 0, At, B0); PG8_MMA(1, 1, At, B1); PG8_BAR; PG8_SCHED;
            } else {
            PG8_LDB(B0, 0, 0); PG8_SCHED; PG8_LDA(At, 0, 0); PG8_STAGE(PG8_SA(1, 1), a1 + hstepA, voffA);
            PG8_WAIT_L(8); PG8_BAR; PG8_WAIT_L(0); PG8_MMA(0, 0, At, B0); PG8_BAR; PG8_SCHED;
            PG8_LDB(B1, 0, 1); PG8_STAGE(PG8_SB(0, 0), b2, voffB);
            PG8_BAR; PG8_WAIT_L(0); PG8_MMA(0, 1, At, B1); PG8_BAR;
            PG8_LDA(At, 0, 1); PG8_STAGE(PG8_SA(0, 0), a2, voffA);
            PG8_BAR; PG8_WAIT_L(0); PG8_MMA(1, 0, At, B0); PG8_BAR; PG8_SCHED;
            PG8_STAGE(PG8_SB(0, 1), b2 + hstepB, voffB);
            PG8_WAIT_V(6); PG8_BAR; PG8_MMA(1, 1, At, B1); PG8_BAR;
            PG8_LDB(B0, 1, 0); PG8_SCHED; PG8_LDA(At, 1, 0); PG8_STAGE(PG8_SA(0, 1), a2 + hstepA, voffA);
            PG8_WAIT_L(8); PG8_BAR; PG8_WAIT_L(0); PG8_MMA(0, 0, At, B0); PG8_BAR; PG8_SCHED;
            PG8_LDB(B1, 1, 1); PG8_STAGE(PG8_SB(1, 0), b3, voffB);
            PG8_BAR; PG8_WAIT_L(0); PG8_MMA(0, 1, At, B1); PG8_BAR;
            PG8_LDA(At, 1, 1); PG8_STAGE(PG8_SA(1, 0), a3, voffA);
            PG8_BAR; PG8_WAIT_L(0); PG8_MMA(1, 0, At, B0); PG8_BAR; PG8_SCHED;
            PG8_STAGE(PG8_SB(1, 1), b3 + hstepB, voffB);
            PG8_WAIT_V(6); PG8_BAR; PG8_MMA(1, 1, At, B1); PG8_BAR;
            }
        }
        if constexpr (ALIGN_EPI) { if (wr == 0) PG8_BAR; }
        if constexpr (!Epi::AFTER_DRAIN) { E(acc, cur, wr, wc, fr, fq); S.done(cur); }
        if (!has_next) break;
#pragma unroll
        for (int a = 0; a < 2; ++a)
#pragma unroll
            for (int b = 0; b < 2; ++b)
#pragma unroll
                for (int m = 0; m < 4; ++m)
#pragma unroll
                    for (int n = 0; n < 2; ++n) acc[a][b][m][n] = (f32x4){0.f, 0.f, 0.f, 0.f};
        cur = nxt; cA = nA; cB = nB; ++ui;
        if constexpr (ALIGN_EPI) { if (wr == 1) PG8_BAR; }
    }
    PG8_WAIT_V(0);
    if constexpr (!ALIGN_EPI) { if (wr == 0) PG8_BAR; }
    PG8_BAR;
    if constexpr (Epi::AFTER_DRAIN) { E.fused(acc, cur, wr, wc, fr, fq, lds, wid, lane); S.done(cur); }
#undef PG8_SA
#undef PG8_SB
#undef PG8_STAGE
#undef PG8_LDA
#undef PG8_LDB
#undef PG8_MMA
#undef PG8_WAIT_V
#undef PG8_WAIT_L
#undef PG8_BAR
#undef PG8_SCHED
}
}
#define GAS __attribute__((address_space(1)))
#define LAS __attribute__((address_space(3)))
typedef unsigned short bf16;
typedef unsigned v4u __attribute__((ext_vector_type(4)));
typedef float f32x4 __attribute__((ext_vector_type(4)));
typedef short bf16x8 __attribute__((ext_vector_type(8)));
typedef GAS unsigned gu32;
typedef GAS unsigned long long gu64;
#define RLX_AGENT __ATOMIC_RELAXED, __HIP_MEMORY_SCOPE_AGENT
#define LDS_WAIT() asm volatile("s_waitcnt lgkmcnt(0)" ::: "memory")
#define VM_WAIT() asm volatile("s_waitcnt vmcnt(0)" ::: "memory")
__device__ __forceinline__ unsigned long long rt() { return __builtin_amdgcn_s_memrealtime(); }
__device__ __forceinline__ unsigned f2bf(float f) { unsigned u = __builtin_bit_cast(unsigned, f); return (u + 0x7fffu + ((u >> 16) & 1u)) >> 16; }
__device__ __forceinline__ unsigned pk2(float lo, float hi) { return f2bf(lo) | (f2bf(hi) << 16); }

#define XB_TMO      128
#define XB_XCNT(j)  (256  + 64 * (j))
#define XB_XSUB(j)  (1280 + 64 * (j))
#define XB_XGEN(j)  (2304 + 64 * (j))
#define XB_TOP      3328
#define XB_TOPGEN   3392
#define XCD_BAR_WORDS 3456
#define XB_SPIN_CAP (1u << 18)

__device__ __forceinline__ unsigned xb_ld(unsigned* p)              { return __hip_atomic_load(p, __ATOMIC_RELAXED, __HIP_MEMORY_SCOPE_AGENT); }
__device__ __forceinline__ unsigned xb_add(unsigned* p, unsigned v) { return __hip_atomic_fetch_add(p, v, __ATOMIC_RELAXED, __HIP_MEMORY_SCOPE_AGENT); }
__device__ __forceinline__ unsigned xb_xcc_id() { return (unsigned)__builtin_amdgcn_s_getreg((3 << 11) | 20) & 0xFu; }
#define XB_SPIN(cond, bar) do { unsigned _sp = 0; while (cond) { __builtin_amdgcn_s_sleep(1); \
    if ((++_sp & 255u) == 0u) { if (xb_ld(&(bar)[XB_TMO])) break; if (_sp > XB_SPIN_CAP) { atomicAdd(&(bar)[XB_TMO], 1u); break; } } } } while (0)

struct XcdBarrier {
    unsigned* bar; unsigned x;
    volatile LAS unsigned* st;
};

__device__ __forceinline__ XcdBarrier xcd_barrier_post(unsigned* bar, volatile LAS unsigned* st) {
    XcdBarrier b; b.bar = bar; b.x = xb_xcc_id(); b.st = st;
    if (threadIdx.x == 0) (void)xb_add(&bar[XB_XCNT(b.x)], 1u);
    return b;
}
__device__ __forceinline__ void xcd_barrier_complete(unsigned* bar, unsigned x, unsigned& nloc, unsigned& nx) {
    const unsigned G = gridDim.x * gridDim.y * gridDim.z;
    unsigned sum, cnt, mine, sp = 0u;
    for (;;) {
        sum = 0u; cnt = 0u; mine = 0u;
#pragma unroll
        for (unsigned j = 0; j < 16; ++j) { const unsigned c = xb_ld(&bar[XB_XCNT(j)]); sum += c; cnt += (c > 0u) ? 1u : 0u; mine = (j == x) ? c : mine; }
        if (sum == G) break;
        __builtin_amdgcn_s_sleep(1);
        if ((++sp & 255u) == 0u) { if (xb_ld(&bar[XB_TMO])) break; if (sp > XB_SPIN_CAP) { atomicAdd(&bar[XB_TMO], 1u); break; } }
    }
    nloc = mine > 0u ? mine : 1u; nx = cnt > 0u ? cnt : 1u;
}

__device__ __forceinline__ void xcd_barrier(const XcdBarrier& b) {
    asm volatile("s_waitcnt vmcnt(0)" ::: "memory");
    __syncthreads();
    if (threadIdx.x == 0) {
        unsigned* bar = b.bar;
        __builtin_amdgcn_s_waitcnt(0);
        unsigned nloc = b.st[0], nx = b.st[1];
        if (nloc == 0u) { xcd_barrier_complete(bar, b.x, nloc, nx); b.st[0] = nloc; b.st[1] = nx; }
        const unsigned old = xb_add(&bar[XB_XSUB(b.x)], 1u);
        const unsigned gen = old / nloc;
        if (old + 1u == (gen + 1u) * nloc) {
            __builtin_amdgcn_fence(__ATOMIC_RELEASE, "agent");
            asm volatile("s_waitcnt vmcnt(0)" ::: "memory");
            const unsigned og = xb_add(&bar[XB_TOP], 1u);
            const unsigned tg = og / nx;
            if (og + 1u == (tg + 1u) * nx) xb_add(&bar[XB_TOPGEN], 1u);
            else XB_SPIN(xb_ld(&bar[XB_TOPGEN]) == tg, bar);
            __builtin_amdgcn_fence(__ATOMIC_ACQUIRE, "agent");
            xb_add(&bar[XB_XGEN(b.x)], 1u);
            asm volatile("s_waitcnt vmcnt(0)" ::: "memory");
        } else {
            XB_SPIN(xb_ld(&bar[XB_XGEN(b.x)]) == gen, bar);
            __builtin_amdgcn_fence(__ATOMIC_ACQUIRE, "agent");
            asm volatile("s_waitcnt vmcnt(0)" ::: "memory");
        }
    }
    __syncthreads();
}
struct Params { const float* in[31]; float* out; unsigned char* ws; int ph_lo, ph_hi; };
enum { I_XP = 0, I_XS, I_CK, I_CV, I_SRE, I_SIM, I_SCONV, I_META, I_GMIX, I_WIN, I_SINKS, I_LAMRE, I_LAMIM, I_LOGDT, I_BRE, I_BIM, I_CRE, I_CIM, I_DSKIP, I_WGLU, I_BGLU, I_GA, I_GS, I_WO, I_GFFN, I_WGATE, I_WUP, I_CONVW, I_CONVB, I_WDOWN, I_GFINAL };
constexpr size_t O_YP = 0, O_YS = O_YP + (size_t)NBATCH * SEQ * D_MODEL, O_PK = O_YS + (size_t)DBATCH * DSEQ * D_MODEL, O_PV = O_PK + NBATCH * WIN * KVW, O_PRE = O_PV + NBATCH * WIN * KVW,
                 O_PIM = O_PRE + NBATCH * NG * SP, O_PC = O_PIM + NBATCH * NG * SP, O_SK = O_PC + NBATCH * 2 * FF, O_SV = O_SK + (size_t)DBATCH * WIN * KVW, O_SRE = O_SV + (size_t)DBATCH * WIN * KVW,
                 O_SIM = O_SRE + DBATCH * NG * SP, O_SC = O_SIM + DBATCH * NG * SP, O_END = O_SC + (size_t)DBATCH * 2 * FF;
static_assert(O_END == 23080960, "output size");

__device__ __forceinline__ float wave_sum(float v) {
#pragma unroll
    for (int o = 1; o < 64; o <<= 1) v += __shfl_xor(v, o);
    return v;
}
__device__ __forceinline__ const float* x_src_row(const Params& p, int r) {
    return r < R_SMP ? p.in[I_XP] + (size_t)r * D_MODEL : (r < R_META ? p.in[I_XS] + (size_t)(r - R_SMP) * D_MODEL : p.in[I_META] + (size_t)(r - R_META) * D_MODEL);
}
__device__ __forceinline__ void p0_transpose_item(const float* W, int K, int N, bf16* WT, int drow0, int k0, int n0, const float* sc, LAS float* scr, int lane) {
#pragma unroll 8
    for (int i = 0; i < 32; ++i) { const int kk = 2 * i + (lane >> 5); float v = W[(size_t)(k0 + kk) * N + n0 + (lane & 31)]; if (sc) v *= sc[k0 + kk]; scr[kk * 33 + (lane & 31)] = v; }
    LDS_WAIT(); asm volatile("" ::: "memory");
    const int c = lane & 7;
#pragma unroll
    for (int j = 0; j < 4; ++j) { const int n = (lane >> 3) + 8 * j; const LAS float* s = scr + (8 * c) * 33 + n;
        v4u o; o.x = pk2(s[0 * 33], s[1 * 33]); o.y = pk2(s[2 * 33], s[3 * 33]); o.z = pk2(s[4 * 33], s[5 * 33]); o.w = pk2(s[6 * 33], s[7 * 33]);
        *(GAS v4u*)(WT + (size_t)(drow0 + n) * K + k0 + 8 * c) = o; }
    LDS_WAIT(); asm volatile("" ::: "memory");
}
__device__ __forceinline__ void rms_row_to_bf16(const float* xrow, bf16* orow, int lane) {
    const GAS f32x4* xr = (const GAS f32x4*)xrow + lane;
    f32x4 v[4]; float s = 0.f;
#pragma unroll
    for (int j = 0; j < 4; ++j) { v[j] = xr[64 * j]; s += (v[j].x * v[j].x + v[j].y * v[j].y) + (v[j].z * v[j].z + v[j].w * v[j].w); }
    const float rs = 1.f / sqrtf(wave_sum(s) * (1.f / D_MODEL) + EPS);
    GAS unsigned long long* o8 = (GAS unsigned long long*)orow + lane;
#pragma unroll
    for (int j = 0; j < 4; ++j) o8[64 * j] = (unsigned long long)pk2(v[j].x * rs, v[j].y * rs) | ((unsigned long long)pk2(v[j].z * rs, v[j].w * rs) << 32);
}
__device__ __forceinline__ double dexp(double x) {
    const double k = __builtin_rint(x * 1.4426950408889634074);
    double r = __builtin_fma(-k, 6.93147180369123816490e-01, x); r = __builtin_fma(-k, 1.90821492927058770002e-10, r);
    double p = 1.0 / 6227020800.0;
    p = __builtin_fma(p, r, 1.0 / 479001600.0); p = __builtin_fma(p, r, 1.0 / 39916800.0); p = __builtin_fma(p, r, 1.0 / 3628800.0); p = __builtin_fma(p, r, 1.0 / 362880.0); p = __builtin_fma(p, r, 1.0 / 40320.0);
    p = __builtin_fma(p, r, 1.0 / 5040.0); p = __builtin_fma(p, r, 1.0 / 720.0); p = __builtin_fma(p, r, 1.0 / 120.0); p = __builtin_fma(p, r, 1.0 / 24.0); p = __builtin_fma(p, r, 1.0 / 6.0); p = __builtin_fma(p, r, 0.5);
    p = __builtin_fma(p, r, 1.0); p = __builtin_fma(p, r, 1.0);
    return p * __longlong_as_double((long long)((int)k + 1023) << 52);
}
__device__ __forceinline__ void dsincos(double x, double& s, double& c) {
    const double k = __builtin_rint(x * 0.63661977236758134308);
    double r = __builtin_fma(-k, 1.57079632679489655800e+00, x); r = __builtin_fma(-k, 6.12323399573676603587e-17, r);
    const int q = (int)((long long)k) & 3; const double r2 = r * r;
    double sp = -1.0 / 1307674368000.0;
    sp = __builtin_fma(sp, r2, 1.0 / 6227020800.0); sp = __builtin_fma(sp, r2, -1.0 / 39916800.0); sp = __builtin_fma(sp, r2, 1.0 / 362880.0); sp = __builtin_fma(sp, r2, -1.0 / 5040.0); sp = __builtin_fma(sp, r2, 1.0 / 120.0); sp = __builtin_fma(sp, r2, -1.0 / 6.0);
    const double sn = __builtin_fma(r * r2, sp, r);
    double cp = 1.0 / 20922789888000.0;
    cp = __builtin_fma(cp, r2, -1.0 / 87178291200.0); cp = __builtin_fma(cp, r2, 1.0 / 479001600.0); cp = __builtin_fma(cp, r2, -1.0 / 3628800.0); cp = __builtin_fma(cp, r2, 1.0 / 40320.0); cp = __builtin_fma(cp, r2, -1.0 / 720.0); cp = __builtin_fma(cp, r2, 1.0 / 24.0); cp = __builtin_fma(cp, r2, -0.5);
    const double cs = __builtin_fma(cp, r2, 1.0);
    s = (q & 1) ? cs : sn; c = (q & 1) ? sn : cs; if (q == 1 || q == 2) c = -c; if (q >= 2) s = -s;
}
__device__ __forceinline__ void p0_ssm_tables(const Params& p, LAS unsigned char* lds, int task, int tid) {
    typedef float f2 __attribute__((ext_vector_type(2)));
    const int g = task >> 3, j = task & 7;
    LAS f2* PW = (LAS f2*)lds;
    LAS f2* BBl = PW + 12 * 64;
    LAS f2* CL = BBl + 64 * 16;
    const float* lam_re = p.in[I_LAMRE] + g * SP; const float* lam_im = p.in[I_LAMIM] + g * SP;
    const double dt = dexp((double)p.in[I_LOGDT][g]);
    for (int idx = tid; idx < 12 * 64; idx += 512) { const int e = idx >> 6, pp = idx & 63; const int ex = e < 4 ? 31 - 4 * j - e : (e < 8 ? 4 * j + 1 + (e - 4) : 4 * j + (e - 8));
        const double zr = (double)lam_re[pp] * dt * ex, zi = (double)lam_im[pp] * dt * ex, m = dexp(zr); double sn, cs; dsincos(zi, sn, cs); PW[idx] = (f2){(float)(m * cs), (float)(m * sn)}; }
    for (int idx = tid; idx < 1024; idx += 512) { const int pp = idx >> 4, c = idx & 15; const double lr = lam_re[pp], li = lam_im[pp], er = dexp(lr * dt); double sn, cs; dsincos(li * dt, sn, cs); const double lbr = er * cs, lbi = er * sn;
        const double nr = lbr - 1.0, ni = lbi, dn = lr * lr + li * li, fr = (nr * lr + ni * li) / dn, fi = (ni * lr - nr * li) / dn;
        const double br = p.in[I_BRE][(g * SP + pp) * SG + c], bi = p.in[I_BIM][(g * SP + pp) * SG + c]; BBl[idx] = (f2){(float)(fr * br - fi * bi), (float)(fr * bi + fi * br)}; }
    for (int idx = tid; idx < 1024; idx += 512) { CL[idx] = (f2){p.in[I_CRE][g * 1024 + idx], p.in[I_CIM][g * 1024 + idx]}; }
    __syncthreads();
    bf16* W1 = (bf16*)(p.ws + WS_W1) + (size_t)g * 128 * 512; bf16* W2 = (bf16*)(p.ws + WS_W2) + (size_t)g * 512 * 128; bf16* KC = (bf16*)(p.ws + WS_KC) + (size_t)g * 33 * 256;
    for (int idx = tid; idx < 4096; idx += 512) { const int s = idx >> 10, pp = (idx >> 4) & 63, ci = idx & 15; const f2 w = PW[s * 64 + pp], b = BBl[pp * 16 + ci];
        const int kk = (4 * j + s) * 16 + ci; W1[(size_t)pp * 512 + kk] = (bf16)f2bf(w.x * b.x - w.y * b.y); W1[(size_t)(64 + pp) * 512 + kk] = (bf16)f2bf(w.x * b.y + w.y * b.x); }
    for (int idx = tid; idx < 4096; idx += 512) { const int s = idx >> 10, co = (idx >> 6) & 15, pp = idx & 63; const f2 w = PW[(4 + s) * 64 + pp], c = CL[co * 64 + pp];
        const int n2 = (4 * j + s) * 16 + co; W2[(size_t)n2 * 128 + pp] = (bf16)f2bf(c.x * w.x - c.y * w.y); W2[(size_t)n2 * 128 + 64 + pp] = (bf16)f2bf(-(c.x * w.y + c.y * w.x)); }
    for (int idx = tid; idx < 1024; idx += 512) { const int s = idx >> 8, co = (idx >> 4) & 15, ci = idx & 15; float acc = 0.f;
#pragma unroll 4
        for (int pp = 0; pp < 64; ++pp) { const f2 w = PW[(8 + s) * 64 + pp], c = CL[co * 64 + pp], b = BBl[pp * 16 + ci]; const float cwr = c.x * w.x - c.y * w.y, cwi = c.x * w.y + c.y * w.x; acc += cwr * b.x - cwi * b.y; }
        KC[(size_t)((4 * j + s) + 1) * 256 + co * 16 + ci] = (bf16)f2bf(acc); }
    if (j == 0) {
        if (tid < 256) KC[tid] = 0;
        if (tid < 64) { const double zr = (double)lam_re[tid] * dt, zi = (double)lam_im[tid] * dt; const double m32 = dexp(32.0 * zr), m1 = dexp(zr); double s32, c32, s1, c1; dsincos(32.0 * zi, s32, c32); dsincos(zi, s1, c1);
            ((f2*)(p.ws + WS_LAMT))[g * SP + tid] = (f2){(float)(m32 * c32), (float)(m32 * s32)}; ((f2*)(p.ws + WS_LB))[g * SP + tid] = (f2){(float)(m1 * c1), (float)(m1 * s1)}; }
        for (int idx = tid; idx < 1024; idx += 512) ((f2*)(p.ws + WS_BB))[g * 1024 + idx] = BBl[idx];
    }
    __syncthreads();
}
__device__ __forceinline__ void p0_prologue(const Params& p, LAS unsigned char* lds, int vcu, int G, int tid, int wave, int lane) {
    for (int task = vcu; task < NG * 8; task += G) p0_ssm_tables(p, lds, task, tid);
    LAS float* scr = (LAS float*)(lds + RING_OFF + wave * 16384);
    const int gw = vcu * NWAVES + wave, NGW = G * NWAVES;
    bf16* WIN_T = (bf16*)(p.ws + WS_WIN); bf16* WGLU_T = (bf16*)(p.ws + WS_WGLU); bf16* WO_T = (bf16*)(p.ws + WS_WO); bf16* WGU_T = (bf16*)(p.ws + WS_WGU); bf16* WD_T = (bf16*)(p.ws + WS_WD);
    constexpr int I_A = 16 * 40, I_B = 8 * 16, I_C = 16 * 32, I_D = 16 * 88, I_E = 44 * 32;
    constexpr int NITEMS = I_A + I_B + I_C + 2 * I_D + I_E;
    for (int it = gw; it < NITEMS; it += NGW) {
        int r = it;
        if (r < I_A) { const int kb = r / 40, nb = r % 40; p0_transpose_item(p.in[I_WIN], 1024, INC, WIN_T, 32 * nb, 64 * kb, 32 * nb, p.in[I_GMIX], scr, lane); continue; } r -= I_A;
        if (r < I_B) { const int kb = r / 16, nb = r % 16; p0_transpose_item(p.in[I_WGLU], 512, 512, WGLU_T, 32 * nb, 64 * kb, 32 * nb, nullptr, scr, lane); continue; } r -= I_B;
        if (r < I_C) { const int kb = r / 32, nb = r % 32; p0_transpose_item(p.in[I_WO], 1024, 1024, WO_T, 32 * nb, 64 * kb, 32 * nb, kb < 8 ? p.in[I_GA] : p.in[I_GS] - 512, scr, lane); continue; } r -= I_C;
        if (r < I_D) { const int kb = r / 88, nb = r % 88, n0 = 32 * nb; p0_transpose_item(p.in[I_WGATE], 1024, FF, WGU_T, 256 * (n0 >> 7) + (n0 & 127), 64 * kb, n0, p.in[I_GFFN], scr, lane); continue; } r -= I_D;
        if (r < I_D) { const int kb = r / 88, nb = r % 88, n0 = 32 * nb; p0_transpose_item(p.in[I_WUP], 1024, FF, WGU_T, 256 * (n0 >> 7) + 128 + (n0 & 127), 64 * kb, n0, p.in[I_GFFN], scr, lane); continue; } r -= I_D;
        { const int kb = r / 32, nb = r % 32; p0_transpose_item(p.in[I_WDOWN], FF, 1024, WD_T, 32 * nb, 64 * kb, 32 * nb, nullptr, scr, lane); }
    }
    bf16* XN = (bf16*)(p.ws + WS_XN);
    for (int m = gw; m < MROWS; m += NGW) {
        if (m < R_END) rms_row_to_bf16(x_src_row(p, m), XN + (size_t)m * D_MODEL, lane);
        else { GAS unsigned long long* o8 = (GAS unsigned long long*)(XN + (size_t)m * D_MODEL) + lane;
#pragma unroll
            for (int j = 0; j < 4; ++j) o8[64 * j] = 0ull; }
    }
    { const int gt = vcu * (NWAVES * 64) + tid, NT = G * NWAVES * 64; constexpr int PER = (WIN - DSEQ) * KVW / 4;
        for (int i = gt; i < 2 * DBATCH * PER; i += NT) { const int kv = i / (DBATCH * PER), r = i % (DBATCH * PER), n = r / PER, q = r % PER;
            const f32x4 v = *((const GAS f32x4*)(p.in[kv ? I_CV : I_CK] + (size_t)n * WIN * KVW + DSEQ * KVW) + q);
            *((GAS f32x4*)(p.out + (kv ? O_SV : O_SK) + (size_t)n * WIN * KVW) + q) = v; } }
}
namespace p2 {
typedef float f32x16 __attribute__((ext_vector_type(16)));
typedef float f32x4 __attribute__((ext_vector_type(4)));
typedef short bf16x8 __attribute__((ext_vector_type(8)));
typedef short s16x4 __attribute__((ext_vector_type(4)));
typedef unsigned u32x4 __attribute__((ext_vector_type(4)));
constexpr float LOG2E = 1.4426950408889634f;
__device__ __forceinline__ int crow(int r, int hi) { return (r & 3) + 8 * (r >> 2) + 4 * hi; }
__device__ __forceinline__ unsigned cvtpk(float lo, float hi) { typedef float f2 __attribute__((ext_vector_type(2))); typedef __bf16 b2 __attribute__((ext_vector_type(2))); f2 v = {lo, hi}; b2 b = __builtin_convertvector(v, b2); return __builtin_bit_cast(unsigned, b); }
__device__ __forceinline__ float bf2f(unsigned short b) { return __uint_as_float((unsigned)b << 16); }
__device__ __forceinline__ s16x4 vtr(LAS const unsigned char* p) { typedef short v4i16_t __attribute__((ext_vector_type(4))); return __builtin_bit_cast(s16x4, __builtin_amdgcn_ds_read_tr16_b64_v4i16((LAS v4i16_t*)p)); }

constexpr int KS = 144, VS = 192;
template <class Mask>
__device__ __forceinline__ void attn_core(const bf16x8 (&qf)[4], LAS const unsigned char* Kl, LAS const unsigned char* Vl, float sink2, const Mask& mask, LAS float* wsf, LAS unsigned short* stg, int lane) {
    const int r32 = lane & 31, hi = lane >> 5;
    f32x16 sc[5];
#pragma unroll
    for (int j = 0; j < 5; ++j) {
        f32x16 a = {0.f, 0.f, 0.f, 0.f, 0.f, 0.f, 0.f, 0.f, 0.f, 0.f, 0.f, 0.f, 0.f, 0.f, 0.f, 0.f};
#pragma unroll
        for (int ks = 0; ks < 4; ++ks) { const bf16x8 kf = *(LAS const bf16x8*)(Kl + (j * 32 + r32) * KS + (16 * ks + 8 * hi) * 2); a = __builtin_amdgcn_mfma_f32_32x32x16_bf16(kf, qf[ks], a, 0, 0, 0); }
        sc[j] = a;
    }
    float m = sink2;
#pragma unroll
    for (int j = 0; j < 5; ++j)
#pragma unroll
        for (int r = 0; r < 16; ++r) { const float v = mask.valid(j * 32 + (r & 3) + 8 * (r >> 2)) ? sc[j][r] : -INFINITY; sc[j][r] = v; m = fmaxf(m, v); }
    m = fmaxf(m, __shfl_xor(m, 32));
    float l = 0.f;
#pragma unroll
    for (int j = 0; j < 5; ++j)
#pragma unroll
        for (int r = 0; r < 16; ++r) { const float e = __builtin_amdgcn_exp2f(sc[j][r] - m); sc[j][r] = e; l += e; }
    l += __shfl_xor(l, 32); l += __builtin_amdgcn_exp2f(sink2 - m);
    f32x16 o[2];
#pragma unroll
    for (int d = 0; d < 2; ++d) o[d] = (f32x16){0.f, 0.f, 0.f, 0.f, 0.f, 0.f, 0.f, 0.f, 0.f, 0.f, 0.f, 0.f, 0.f, 0.f, 0.f, 0.f};
    LAS const unsigned char* vbase = Vl + (4 * hi + ((lane & 15) >> 2)) * VS + (16 * ((lane >> 4) & 1) + 4 * (lane & 3)) * 2;
#pragma unroll
    for (int j = 0; j < 5; ++j)
#pragma unroll
        for (int s = 0; s < 2; ++s) {
            u32x4 pw; pw.x = cvtpk(sc[j][8 * s + 0], sc[j][8 * s + 1]); pw.y = cvtpk(sc[j][8 * s + 2], sc[j][8 * s + 3]); pw.z = cvtpk(sc[j][8 * s + 4], sc[j][8 * s + 5]); pw.w = cvtpk(sc[j][8 * s + 6], sc[j][8 * s + 7]);
            const bf16x8 pa = __builtin_bit_cast(bf16x8, pw);
#pragma unroll
            for (int d = 0; d < 2; ++d) {
                const s16x4 lo = vtr(vbase + (j * 32 + 16 * s) * VS + d * 64), hh = vtr(vbase + (j * 32 + 16 * s + 8) * VS + d * 64);
                const bf16x8 vf = {lo[0], lo[1], lo[2], lo[3], hh[0], hh[1], hh[2], hh[3]};
                o[d] = __builtin_amdgcn_mfma_f32_32x32x16_bf16(pa, vf, o[d], 0, 0, 0);
            }
        }
    if (hi == 0) wsf[r32] = 1.0f / l;
    asm volatile("s_waitcnt lgkmcnt(0)" ::: "memory");
#pragma unroll
    for (int r = 0; r < 16; ++r) { const int orow = crow(r, hi); const float rl = wsf[orow];
#pragma unroll
        for (int d = 0; d < 2; ++d) stg[orow * 64 + d * 32 + r32] = (unsigned short)(cvtpk(o[d][r] * rl, 0.f) & 0xffffu); }
    asm volatile("s_waitcnt lgkmcnt(0)" ::: "memory");
}
__device__ __forceinline__ void attn_store(LAS const unsigned short* stg, unsigned short* AO, float* ssq, int frow0, int col0, int rlo, int rhi, int lane) {
#pragma unroll
    for (int i = 0; i < 4; ++i) { const int row = i * 8 + (lane >> 3), ch = lane & 7; const u32x4 v = *(LAS const u32x4*)(stg + row * 64 + ch * 8);
        float s = 0.f;
#pragma unroll
        for (int e = 0; e < 4; ++e) { const float a = __uint_as_float(v[e] << 16), b = __uint_as_float(v[e] & 0xffff0000u); s += a * a + b * b; }
        s += __shfl_xor(s, 1); s += __shfl_xor(s, 2); s += __shfl_xor(s, 4);
        if (row >= rlo && row < rhi) { *(GAS u32x4*)(AO + (size_t)(frow0 + row) * D_MODEL + col0 + ch * 8) = v; if (ch == 0) atomicAdd(ssq + frow0 + row, s); } }
}
constexpr int AL_K = 0, AL_V = 256 * KS, AL_WS = AL_V + 256 * VS, AL_ST = AL_WS + NWAVES * 256, AL_END = AL_ST + NWAVES * 4096;
static_assert(AL_END <= RING_BYTES, "attention LDS");
struct PMask { int qq, sm2;
    __device__ __forceinline__ PMask(int r0, int smin, int lane) : qq((lane & 31) - 4 * (lane >> 5)), sm2(smin - r0 - 4 * (lane >> 5)) {}
    __device__ __forceinline__ bool valid(int K0) const { return K0 > qq && K0 <= qq + 128 && K0 >= sm2; } };
__device__ __forceinline__ void attn_prompt_unit(const Params& p, LAS unsigned char* lds, int qbase, int rmin, int kprev, int kcur, int smin, int kvh, int tid, int wave, int lane) {
    const unsigned short* KB = (const unsigned short*)(p.ws + WS_KB); const unsigned short* VB = (const unsigned short*)(p.ws + WS_VB); const unsigned short* QB = (const unsigned short*)(p.ws + WS_QB);
    unsigned short* AO = (unsigned short*)(p.ws + WS_AO); float* ssq = (float*)(p.ws + CTL_SSQ_A);
#pragma unroll
    for (int it = 0; it < 4; ++it) { const int idx = it * 512 + tid, s = idx >> 3, ch = idx & 7; const int row = s < 128 ? kprev + s : kcur + (s - 128);
        u32x4 kv = {0u, 0u, 0u, 0u}, vv = {0u, 0u, 0u, 0u};
        if (s >= smin) { kv = *(const GAS u32x4*)(KB + (size_t)row * KVW + kvh * 64 + ch * 8); vv = *(const GAS u32x4*)(VB + (size_t)row * KVW + kvh * 64 + ch * 8); }
        *(LAS u32x4*)(lds + AL_K + s * KS + ch * 16) = kv; *(LAS u32x4*)(lds + AL_V + s * VS + ch * 16) = vv; }
    __syncthreads();
    const int g = wave >> 1, hf = wave & 1, h = kvh * 4 + g, r32 = lane & 31, hi = lane >> 5;
    const float sink2 = p.in[I_SINKS][h] * LOG2E;
    LAS float* wsf = (LAS float*)(lds + AL_WS + wave * 256); LAS unsigned short* stg = (LAS unsigned short*)(lds + AL_ST + wave * 4096);
    for (int qb = 0; qb < 2; ++qb) {
        const int r0 = hf * 64 + qb * 32;
        if (r0 + 32 <= rmin) continue;
        const int rq = (r0 + r32) >= rmin ? r0 + r32 : rmin;
        const unsigned short* qp = QB + (size_t)(qbase + rq) * AW + h * 64 + hi * 8;
        bf16x8 qf[4];
#pragma unroll
        for (int ks = 0; ks < 4; ++ks) qf[ks] = *(const GAS bf16x8*)(qp + ks * 16);
        const PMask mk(r0, smin, lane);
        attn_core(qf, lds + AL_K + r0 * KS, lds + AL_V + r0 * VS, sink2, mk, wsf, stg, lane);
        attn_store(stg, AO, ssq, qbase + r0, h * 64, rmin > r0 ? rmin - r0 : 0, 32, lane);
    }
    __syncthreads();
}
constexpr int SL_K = 0, SL_V = 2 * 160 * KS, SL_WS = SL_V + 2 * 160 * VS, SL_ST = SL_WS + NWAVES * 256, SL_END = SL_ST + NWAVES * 4096;
static_assert(SL_END <= LDSCTL_OFF, "sample attention LDS");
struct SMask { int tt;
    __device__ __forceinline__ explicit SMask(int lane) : tt((lane & 3) - 4 * (lane >> 5)) {}
    __device__ __forceinline__ bool valid(int K0) const { return K0 < 128 ? K0 > tt : (K0 - 128) <= tt; } };
__device__ __forceinline__ void attn_sample_unit(const Params& p, LAS unsigned char* lds, int n, int tid, int wave, int lane) {
    const unsigned short* KB = (const unsigned short*)(p.ws + WS_KB); const unsigned short* VB = (const unsigned short*)(p.ws + WS_VB); const unsigned short* QB = (const unsigned short*)(p.ws + WS_QB);
    unsigned short* AO = (unsigned short*)(p.ws + WS_AO); float* ssq = (float*)(p.ws + CTL_SSQ_A);
    const float* ck = p.in[I_CK] + (size_t)n * WIN * KVW; const float* cv = p.in[I_CV] + (size_t)n * WIN * KVW;
    for (int idx = tid; idx < 2 * 160 * 8; idx += 512) { const int kvh = idx / 1280, rem = idx % 1280, s = rem >> 3, ch = rem & 7;
        u32x4 kv = {0u, 0u, 0u, 0u}, vv = {0u, 0u, 0u, 0u};
        if (s < 128) { const f32x4 a = *(const GAS f32x4*)(ck + (size_t)s * KVW + kvh * 64 + ch * 8), b = *(const GAS f32x4*)(ck + (size_t)s * KVW + kvh * 64 + ch * 8 + 4);
            const f32x4 c = *(const GAS f32x4*)(cv + (size_t)s * KVW + kvh * 64 + ch * 8), d = *(const GAS f32x4*)(cv + (size_t)s * KVW + kvh * 64 + ch * 8 + 4);
            kv = (u32x4){cvtpk(a[0], a[1]), cvtpk(a[2], a[3]), cvtpk(b[0], b[1]), cvtpk(b[2], b[3])}; vv = (u32x4){cvtpk(c[0], c[1]), cvtpk(c[2], c[3]), cvtpk(d[0], d[1]), cvtpk(d[2], d[3])}; }
        else if (s < 132) { const int row = R_SMP + 4 * n + (s - 128); kv = *(const GAS u32x4*)(KB + (size_t)row * KVW + kvh * 64 + ch * 8); vv = *(const GAS u32x4*)(VB + (size_t)row * KVW + kvh * 64 + ch * 8); }
        *(LAS u32x4*)(lds + SL_K + (kvh * 160 + s) * KS + ch * 16) = kv; *(LAS u32x4*)(lds + SL_V + (kvh * 160 + s) * VS + ch * 16) = vv; }
    __syncthreads();
    const int h = wave, kvh = h >> 2, r32 = lane & 31, hi = lane >> 5;
    const float sink2 = p.in[I_SINKS][h] * LOG2E;
    LAS float* wsf = (LAS float*)(lds + SL_WS + wave * 256); LAS unsigned short* stg = (LAS unsigned short*)(lds + SL_ST + wave * 4096);
    const unsigned short* qp = QB + (size_t)(R_SMP + 4 * n + (r32 & 3)) * AW + h * 64 + hi * 8;
    bf16x8 qf[4];
#pragma unroll
    for (int ks = 0; ks < 4; ++ks) qf[ks] = *(const GAS bf16x8*)(qp + ks * 16);
    const SMask mk(lane);
    attn_core(qf, lds + SL_K + kvh * 160 * KS, lds + SL_V + kvh * 160 * VS, sink2, mk, wsf, stg, lane);
    attn_store(stg, AO, ssq, R_SMP + 4 * n, h * 64, 0, 4, lane);
    __syncthreads();
}

constexpr int CS = 1056;
constexpr int SS_UL = 0, SS_S = 65 * CS, SS_H = SS_S + 65 * 128 * 4, SS_KC = SS_H + 80 * 272, SS_END = SS_KC + 33 * 512;
static_assert(SS_END <= LDSCTL_OFF && SS_S % 16 == 0 && SS_H % 16 == 0 && SS_KC % 16 == 0, "ssm LDS");
__device__ __forceinline__ float gelu_tanh(float y) { const float z = 0.7978845608028654f * (y + 0.044715f * y * y * y); return y / (1.0f + __builtin_amdgcn_exp2f(-2.0f * LOG2E * z)); }
__device__ __forceinline__ void ssm_item(const Params& p, LAS unsigned char* lds, int b, int g, int tid, int wave, int lane) {
    typedef float f2 __attribute__((ext_vector_type(2)));
    const unsigned short* UGg = (const unsigned short*)(p.ws + WS_UG) + (size_t)g * MROWS * 16; unsigned short* GGg = (unsigned short*)(p.ws + WS_GG) + (size_t)g * MROWS * 16;
    const unsigned short* W1 = (const unsigned short*)(p.ws + WS_W1) + (size_t)g * 128 * 512; const unsigned short* W2 = (const unsigned short*)(p.ws + WS_W2) + (size_t)g * 512 * 128;
    const unsigned short* KCg = (const unsigned short*)(p.ws + WS_KC) + (size_t)g * 33 * 256;
    for (int idx = tid; idx < 65 * 64; idx += 512) { const int j = idx >> 6, pc = idx & 63, sp = pc >> 1, half = pc & 1;
        int row = -1; if (j == 0) { if (sp >= 16) row = R_META + (sp - 16); } else row = b * SEQ + 32 * (j - 1) + sp;
        u32x4 v = {0u, 0u, 0u, 0u}; if (row >= 0) v = *(const GAS u32x4*)(UGg + (size_t)row * 16 + half * 8);
        *(LAS u32x4*)(lds + SS_UL + j * CS + sp * 32 + half * 16) = v; }
    for (int idx = tid; idx < 33 * 32; idx += 512) *(LAS u32x4*)(lds + SS_KC + idx * 16) = *(const GAS u32x4*)(KCg + idx * 8);
    __syncthreads();
    const int rr = lane & 15, kq = lane >> 4;
    LAS float* S = (LAS float*)(lds + SS_S); LAS unsigned short* Hb = (LAS unsigned short*)(lds + SS_H);
    int chb[5];
#pragma unroll
    for (int rb = 0; rb < 5; ++rb) { const int ch = 16 * rb + rr; chb[rb] = SS_UL + (ch > 64 ? 64 : ch) * CS + (kq >> 1) * 32 + (kq & 1) * 16; }
    {
        f32x4 acc[5];
#pragma unroll
        for (int rb = 0; rb < 5; ++rb) acc[rb] = (f32x4){0.f, 0.f, 0.f, 0.f};
        const unsigned short* w1p = W1 + (size_t)(16 * wave + rr) * 512 + 8 * kq;
#pragma unroll 4
        for (int ks = 0; ks < 16; ++ks) {
            const bf16x8 bfr = *(const GAS bf16x8*)(w1p + 32 * ks);
#pragma unroll
            for (int rb = 0; rb < 5; ++rb) { const bf16x8 afr = *(LAS const bf16x8*)(lds + chb[rb] + ks * 64); acc[rb] = __builtin_amdgcn_mfma_f32_16x16x32_bf16(afr, bfr, acc[rb], 0, 0, 0); }
        }
#pragma unroll
        for (int rb = 0; rb < 5; ++rb)
#pragma unroll
            for (int r = 0; r < 4; ++r) { const int j = 16 * rb + 4 * kq + r; if (j < 65) S[j * 128 + 16 * wave + rr] = acc[rb][r]; }
    }
    __syncthreads();
    if (tid < 64) {
        const f2 lt = ((const f2*)(p.ws + WS_LAMT))[g * SP + tid]; float hr = 0.f, hi = 0.f;
        for (int j = 0; j < 65; ++j) { Hb[j * 136 + tid] = (unsigned short)(cvtpk(hr, 0.f) & 0xffffu); Hb[j * 136 + 64 + tid] = (unsigned short)(cvtpk(hi, 0.f) & 0xffffu);
            const float sr = S[j * 128 + tid], si = S[j * 128 + 64 + tid]; const float nr = lt.x * hr - lt.y * hi + sr, ni = lt.x * hi + lt.y * hr + si; hr = nr; hi = ni; }
        p.out[O_PRE + ((size_t)b * NG + g) * SP + tid] = hr; p.out[O_PIM + ((size_t)b * NG + g) * SP + tid] = hi;
    }
    __syncthreads();
    {
        const int tq0 = wave, tq1 = 15 - wave, tq2 = 16 + wave, tq3 = 31 - wave;
        f32x4 acc[4][5];
#pragma unroll
        for (int q = 0; q < 4; ++q)
#pragma unroll
            for (int rb = 0; rb < 5; ++rb) acc[q][rb] = (f32x4){0.f, 0.f, 0.f, 0.f};
#define SSM_TOEP(q, tq) if (((tq) >> 1) >= ks) { const int t1 = (tq) - (2 * ks + (kq >> 1)) + 1; const bf16x8 bfr = *(LAS const bf16x8*)(lds + SS_KC + (t1 > 0 ? t1 : 0) * 512 + rr * 32 + (kq & 1) * 16); \
            _Pragma("unroll") for (int rb = 0; rb < 5; ++rb) acc[q][rb] = __builtin_amdgcn_mfma_f32_16x16x32_bf16(afr[rb], bfr, acc[q][rb], 0, 0, 0); }
        for (int ks = 0; ks < 16; ++ks) {
            bf16x8 afr[5];
#pragma unroll
            for (int rb = 0; rb < 5; ++rb) afr[rb] = *(LAS const bf16x8*)(lds + chb[rb] + ks * 64);
            SSM_TOEP(0, tq0) SSM_TOEP(1, tq1) SSM_TOEP(2, tq2) SSM_TOEP(3, tq3)
        }
#undef SSM_TOEP
#define SSM_INTER(q, tq) { const bf16x8 bfr = *(const GAS bf16x8*)(W2 + (size_t)((tq) * 16 + rr) * 128 + 32 * ks + 8 * kq); \
            _Pragma("unroll") for (int rb = 0; rb < 5; ++rb) acc[q][rb] = __builtin_amdgcn_mfma_f32_16x16x32_bf16(afr[rb], bfr, acc[q][rb], 0, 0, 0); }
#pragma unroll
        for (int ks = 0; ks < 4; ++ks) {
            bf16x8 afr[5];
#pragma unroll
            for (int rb = 0; rb < 5; ++rb) afr[rb] = *(LAS const bf16x8*)(lds + SS_H + (16 * rb + rr) * 272 + (32 * ks + 8 * kq) * 2);
            SSM_INTER(0, tq0) SSM_INTER(1, tq1) SSM_INTER(2, tq2) SSM_INTER(3, tq3)
        }
#undef SSM_INTER
        const float dsk = p.in[I_DSKIP][g * SG + rr];
asm volatile("s_waitcnt lgkmcnt(0)" ::: "memory"); __syncthreads();
#define SSM_EPI(q, tq) _Pragma("unroll") for (int rb = 0; rb < 5; ++rb) _Pragma("unroll") for (int r = 0; r < 4; ++r) { if (rb < 4 || (kq == 0 && r == 0)) { \
            LAS unsigned short* up = (LAS unsigned short*)(lds + SS_UL + (4 * kq) * CS + (tq) * 32 + rr * 2 + (16 * rb + r) * CS); const float y = acc[q][rb][r] + dsk * bf2f(*up); \
            *up = (unsigned short)(cvtpk(gelu_tanh(y), 0.f) & 0xffffu); } }
        SSM_EPI(0, tq0) SSM_EPI(1, tq1) SSM_EPI(2, tq2) SSM_EPI(3, tq3)
#undef SSM_EPI
    }
    asm volatile("s_waitcnt lgkmcnt(0)" ::: "memory"); __syncthreads();
    for (int idx = tid; idx < 65 * 64; idx += 512) { const int j = idx >> 6, pc = idx & 63, sp = pc >> 1, half = pc & 1;
        int row = -1; if (j == 0) { if (sp >= 16 && b == 0) row = R_META + (sp - 16); } else row = b * SEQ + 32 * (j - 1) + sp;
        if (row >= 0) *(GAS u32x4*)(GGg + (size_t)row * 16 + half * 8) = *(LAS const u32x4*)(lds + SS_UL + j * CS + sp * 32 + half * 16); }
    __syncthreads();
}
__device__ __forceinline__ void ssm_sample_task(const Params& p, LAS float* hs, int n, int g, int lane) {
    typedef float f2 __attribute__((ext_vector_type(2)));
    const unsigned short* UGg = (const unsigned short*)(p.ws + WS_UG) + (size_t)g * MROWS * 16; unsigned short* GGg = (unsigned short*)(p.ws + WS_GG) + (size_t)g * MROWS * 16;
    const f2 lb = ((const f2*)(p.ws + WS_LB))[g * SP + lane]; const f2* bb = (const f2*)(p.ws + WS_BB) + (size_t)(g * SP + lane) * SG;
    f2 bbr[SG];
#pragma unroll
    for (int c = 0; c < SG; ++c) bbr[c] = bb[c];
    float hr = p.in[I_SRE][((size_t)n * NG + g) * SP + lane], hi = p.in[I_SIM][((size_t)n * NG + g) * SP + lane];
#pragma unroll
    for (int t = 0; t < DSEQ; ++t) {
        const unsigned short* ur = UGg + (size_t)(R_SMP + 4 * n + t) * 16; float br = 0.f, bi = 0.f;
#pragma unroll
        for (int c = 0; c < SG; ++c) { const float uc = bf2f(ur[c]); br += bbr[c].x * uc; bi += bbr[c].y * uc; }
        const float nr = lb.x * hr - lb.y * hi + br, ni = lb.x * hi + lb.y * hr + bi; hr = nr; hi = ni;
        hs[(t * 64 + lane) * 2] = hr; hs[(t * 64 + lane) * 2 + 1] = hi;
    }
    p.out[O_SRE + ((size_t)n * NG + g) * SP + lane] = hr; p.out[O_SIM + ((size_t)n * NG + g) * SP + lane] = hi;
    asm volatile("s_waitcnt lgkmcnt(0)" ::: "memory");
    const int t = lane >> 4, co = lane & 15; const float* cr = p.in[I_CRE] + (size_t)(g * SG + co) * SP; const float* ci = p.in[I_CIM] + (size_t)(g * SG + co) * SP;
    float acc = 0.f;
#pragma unroll 8
    for (int pp = 0; pp < SP; ++pp) acc += cr[pp] * hs[(t * 64 + pp) * 2] - ci[pp] * hs[(t * 64 + pp) * 2 + 1];
    const size_t row = (size_t)(R_SMP + 4 * n + t);
    const float y = acc + p.in[I_DSKIP][g * SG + co] * bf2f(UGg[row * 16 + co]);
    GGg[row * 16 + co] = (unsigned short)(cvtpk(gelu_tanh(y), 0.f) & 0xffffu);
    asm volatile("s_waitcnt lgkmcnt(0)" ::: "memory");
}
__device__ __forceinline__ void p2_phase(const Params& p, LAS unsigned char* lds, int vcu, int G, int tid, int wave, int lane) {
    for (int u = vcu; u < 258; u += G) {
        if (u < 256) { const int b = u >> 5, i = 1 + ((u >> 1) & 15), kvh = u & 1, qbase = b * SEQ + 128 * (i - 1);
            attn_prompt_unit(p, lds, qbase, 0, i == 1 ? R_META - 112 : qbase - 128, qbase, i == 1 ? 112 : 0, kvh, tid, wave, lane); }
        else attn_prompt_unit(p, lds, R_META - 112, 112, 0, R_META - 112, 240, u - 256, tid, wave, lane);
    }
    for (int n = G - 1 - vcu; n < DBATCH; n += G) attn_sample_unit(p, lds, n, tid, wave, lane);
    for (int it = vcu; it < NBATCH * NG; it += G) ssm_item(p, lds, it >> 5, it & 31, tid, wave, lane);
    for (int id = vcu * NWAVES + wave; id < DBATCH * NG; id += G * NWAVES) ssm_sample_task(p, (LAS float*)(lds + wave * 2048), id >> 5, id & 31, lane);
}
}
namespace pg8 {
struct EpiProj {
    static constexpr bool PERM = true, AFTER_DRAIN = false, MID = false;
    unsigned char* ws; float* out;
    __device__ __forceinline__ void mid(f32x4 (&)[2][2][4][2], const Unit&, int, int, int, int) const {}
    __device__ __forceinline__ void operator()(const f32x4 (&acc)[2][2][4][2], const Unit& u, int wr, int wc, int fr, int fq) const {
        bf16_t* QB = (bf16_t*)(ws + WS_QB); bf16_t* KB = (bf16_t*)(ws + WS_KB); bf16_t* VB = (bf16_t*)(ws + WS_VB); bf16_t* UG = (bf16_t*)(ws + WS_UG);
        const int row0 = u.pm * BM + wr * 64 + fr, c0 = wc * 32 + 8 * fq;
#pragma unroll
        for (int ai = 0; ai < 2; ++ai)
#pragma unroll
            for (int m = 0; m < 4; ++m) {
                const int row = row0 + ai * HALF + m * 16;
#pragma unroll
                for (int bj = 0; bj < 2; ++bj) {
                    const f32x4 v0 = acc[ai][bj][m][0], v1 = acc[ai][bj][m][1];
                    if (u.pn < 2) {
                        u32x4 w; w.x = cvt_pk_bf16(v0[0] * QSCALE, v0[1] * QSCALE); w.y = cvt_pk_bf16(v0[2] * QSCALE, v0[3] * QSCALE); w.z = cvt_pk_bf16(v1[0] * QSCALE, v1[1] * QSCALE); w.w = cvt_pk_bf16(v1[2] * QSCALE, v1[3] * QSCALE);
                        *(u32x4*)(QB + (size_t)row * AW + u.pn * 256 + bj * HALF + c0) = w;
                    } else if (u.pn == 2) {
                        u32x4 w; w.x = cvt_pk_bf16(v0[0], v0[1]); w.y = cvt_pk_bf16(v0[2], v0[3]); w.z = cvt_pk_bf16(v1[0], v1[1]); w.w = cvt_pk_bf16(v1[2], v1[3]);
                        *(u32x4*)((bj ? VB : KB) + (size_t)row * KVW + c0) = w;
                        float* o = nullptr;
                        if (row < R_SMP) { const int t = row & (SEQ - 1); if (t >= SEQ - WIN) o = out + (bj ? O_PV : O_PK) + ((size_t)(row >> 11) * WIN + (t - (SEQ - WIN))) * KVW + c0; }
                        else if (row < R_META) { const int rs = row - R_SMP; o = out + (bj ? O_SV : O_SK) + ((size_t)(rs >> 2) * WIN + (WIN - DSEQ) + (rs & 3)) * KVW + c0; }
                        if (o) { *(f32x4*)o = v0; *(f32x4*)(o + 4) = v1; }
                    } else {
                        const int uc = (u.pn - 3) * 256 + bj * HALF + c0;
                        u32x4 w; w.x = cvt_pk_bf16(v0[0], v0[1]); w.y = cvt_pk_bf16(v0[2], v0[3]); w.z = cvt_pk_bf16(v1[0], v1[1]); w.w = cvt_pk_bf16(v1[2], v1[3]);
                        *(u32x4*)(UG + ((size_t)(uc >> 4) * MROWS + row) * 16 + (uc & 15)) = w;
                    }
                }
            }
    }
};

__device__ __forceinline__ float row_sum4(float v) { v += __shfl_xor(v, 16); v += __shfl_xor(v, 32); return v; }
__device__ __forceinline__ float dpp_ror1(float v) { return __builtin_bit_cast(float, __builtin_amdgcn_update_dpp(0, __builtin_bit_cast(int, v), 0x121, 0xf, 0xf, false)); }
__device__ __forceinline__ float dpp_ror2(float v) { return __builtin_bit_cast(float, __builtin_amdgcn_update_dpp(0, __builtin_bit_cast(int, v), 0x122, 0xf, 0xf, false)); }
__device__ __forceinline__ float bf_lo(unsigned w) { return __uint_as_float(w << 16); }
__device__ __forceinline__ float bf_hi(unsigned w) { return __uint_as_float(w & 0xffff0000u); }
constexpr float LOG2E_F = 1.4426950408889634f;
struct EpiGlu {
    static constexpr bool PERM = true, AFTER_DRAIN = false, MID = false;
    unsigned char* ws; const float* b_glu;
    __device__ __forceinline__ void mid(f32x4 (&)[2][2][4][2], const Unit&, int, int, int, int) const {}
    __device__ __forceinline__ void operator()(const f32x4 (&acc)[2][2][4][2], const Unit& u, int wr, int wc, int fr, int fq) const {
        const bf16_t* GG = (const bf16_t*)(ws + WS_GG); bf16_t* AO = (bf16_t*)(ws + WS_AO); float* ssq_s = (float*)(ws + CTL_SSQ_S);
        const int row0 = u.pm * BM + wr * 64 + fr, c0 = u.pn * BM + wc * 32 + 8 * fq;
        f32x4 bv[2][2];
#pragma unroll
        for (int bj = 0; bj < 2; ++bj)
#pragma unroll
            for (int n = 0; n < 2; ++n) bv[bj][n] = *(const f32x4*)(b_glu + c0 + bj * HALF + 4 * n);
#pragma unroll
        for (int ai = 0; ai < 2; ++ai)
#pragma unroll
            for (int m = 0; m < 4; ++m) {
                const int row = row0 + ai * HALF + m * 16; float ss = 0.f;
#pragma unroll
                for (int bj = 0; bj < 2; ++bj) {
                    const int col = c0 + bj * HALF;
                    const u32x4 gw = *(const u32x4*)(GG + ((size_t)(col >> 4) * MROWS + row) * 16 + (col & 15));
                    const f32x4 z0 = acc[ai][bj][m][0] + bv[bj][0], z1 = acc[ai][bj][m][1] + bv[bj][1];
                    float o[8]; const float gg[8] = {bf_lo(gw.x), bf_hi(gw.x), bf_lo(gw.y), bf_hi(gw.y), bf_lo(gw.z), bf_hi(gw.z), bf_lo(gw.w), bf_hi(gw.w)};
#pragma unroll
                    for (int e = 0; e < 8; ++e) { const float z = e < 4 ? z0[e] : z1[e - 4]; o[e] = gg[e] / (1.0f + __builtin_amdgcn_exp2f(-LOG2E_F * z)); ss += o[e] * o[e]; }
                    u32x4 w; w.x = cvt_pk_bf16(o[0], o[1]); w.y = cvt_pk_bf16(o[2], o[3]); w.z = cvt_pk_bf16(o[4], o[5]); w.w = cvt_pk_bf16(o[6], o[7]);
                    *(u32x4*)(AO + (size_t)row * D_MODEL + SW + col) = w;
                }
                ss = row_sum4(ss); if (fq == 0) atomicAdd(ssq_s + row, ss);
            }
    }
};
struct EpiMix {
    static constexpr bool PERM = true, AFTER_DRAIN = false, MID = true;
    unsigned char* ws; float* out; const float *xp, *xs, *meta;
    __device__ __forceinline__ void mid(f32x4 (&acc)[2][2][4][2], const Unit& u, int wr, int wc, int fr, int fq) const {
        const float* ssq_a = (const float*)(ws + CTL_SSQ_A); const float* ssq_s = (const float*)(ws + CTL_SSQ_S);
        int row0 = u.pm * BM + wr * 64 + fr; asm volatile("" : "+v"(row0));
#pragma unroll
        for (int ai = 0; ai < 2; ++ai)
#pragma unroll
            for (int m = 0; m < 4; ++m) { const int row = row0 + ai * HALF + m * 16;
                const float sa = 1.0f / sqrtf(ssq_a[row] * (1.0f / AW) + EPS), ss = 1.0f / sqrtf(ssq_s[row] * (1.0f / SW) + EPS), f = sa / ss;
#pragma unroll
                for (int bj = 0; bj < 2; ++bj)
#pragma unroll
                    for (int n = 0; n < 2; ++n) acc[ai][bj][m][n] *= f;
                asm volatile("" ::: "memory"); }
    }
    __device__ __forceinline__ void operator()(const f32x4 (&acc)[2][2][4][2], const Unit& u, int wr, int wc, int fr, int fq) const {
        const float* ssq_s = (const float*)(ws + CTL_SSQ_S); float* ssq_x1 = (float*)(ws + CTL_SSQ_X1); bf16_t* XG = (bf16_t*)(ws + WS_XN);
        const unsigned long long xa = (unsigned long long)xp, xb_ = (unsigned long long)xs, xc = (unsigned long long)meta, oa = (unsigned long long)(out + O_YP), obb = (unsigned long long)(out + O_YS), oc = (unsigned long long)(ws + WS_X1M);
        const float* xb = (const float*)(u.pm < 64 ? xa : (u.pm < 66 ? xb_ : xc)); float* ob = (float*)(u.pm < 64 ? oa : (u.pm < 66 ? obb : oc));
        const int rsub = u.pm < 64 ? 0 : (u.pm < 66 ? R_SMP : R_META), xrows = u.pm < 66 ? 0x7fffffff : NMETA;
        const int row0 = u.pm * BM + wr * 64 + fr, c0 = u.pn * BM + wc * 32 + 8 * fq;
#pragma unroll
        for (int ai = 0; ai < 2; ++ai)
#pragma unroll
            for (int m = 0; m < 4; ++m) {
                const int row = row0 + ai * HALF + m * 16, lr = row - rsub;
                const float ss = 1.0f / sqrtf(ssq_s[(unsigned)row] * (1.0f / SW) + EPS);
                float sq = 0.f;
#pragma unroll
                for (int bj = 0; bj < 2; ++bj) {
                    const unsigned off = (unsigned)(lr * D_MODEL + c0 + bj * HALF);
                    f32x4 x0 = {0.f, 0.f, 0.f, 0.f}, x1 = {0.f, 0.f, 0.f, 0.f};
                    if (lr < xrows) { x0 = *(const f32x4*)(xb + off); x1 = *(const f32x4*)(xb + off + 4); }
                    const f32x4 v0 = x0 + acc[ai][bj][m][0] * ss, v1 = x1 + acc[ai][bj][m][1] * ss;
                    *(f32x4*)(ob + off) = v0; *(f32x4*)(ob + off + 4) = v1;
                    u32x4 w; w.x = cvt_pk_bf16(v0[0], v0[1]); w.y = cvt_pk_bf16(v0[2], v0[3]); w.z = cvt_pk_bf16(v1[0], v1[1]); w.w = cvt_pk_bf16(v1[2], v1[3]);
                    *(u32x4*)(XG + (unsigned)(row * D_MODEL + c0 + bj * HALF)) = w;
                    sq += (v0[0] * v0[0] + v0[1] * v0[1]) + (v0[2] * v0[2] + v0[3] * v0[3]) + (v1[0] * v1[0] + v1[1] * v1[1]) + (v1[2] * v1[2] + v1[3] * v1[3]);
                }
                sq = row_sum4(sq); if (fq == 0) atomicAdd(ssq_x1 + (unsigned)row, sq);
                asm volatile("" ::: "memory");
            }
    }
};
struct EpiGateUp {
    static constexpr bool PERM = true, AFTER_DRAIN = false, MID = false;
    unsigned char* ws; float* out; const float *conv_w, *conv_b, *sconv;
    __device__ __forceinline__ void mid(f32x4 (&)[2][2][4][2], const Unit&, int, int, int, int) const {}
    __device__ __forceinline__ void operator()(const f32x4 (&acc)[2][2][4][2], const Unit& u, int wr, int wc, int fr, int fq) const {
        bf16_t* HB = (bf16_t*)(ws + WS_HB); const float* ssq_x1 = (const float*)(ws + CTL_SSQ_X1);
        float* cvg = (float*)(ws + WS_CVG); float* cv0 = (float*)(ws + WS_CV0); float* metag = (float*)(ws + WS_METAG);
        const int f0 = u.pn * HALF + wc * 32 + 8 * fq, rowb = u.pm * BM + wr * HALF + fr;
        const bool smp = (u.pm == 64 || u.pm == 65), mta = (u.pm == 66);
        float w0[8], w1[8], w2[8], cb[8];
#pragma unroll
        for (int h = 0; h < 2; ++h) { const f32x4 a = *(const f32x4*)(conv_w + f0 + 4 * h), b = *(const f32x4*)(conv_w + FF + f0 + 4 * h), c = *(const f32x4*)(conv_w + 2 * FF + f0 + 4 * h), d = *(const f32x4*)(conv_b + f0 + 4 * h);
#pragma unroll
            for (int e = 0; e < 4; ++e) { w0[4 * h + e] = a[e]; w1[4 * h + e] = b[e]; w2[4 * h + e] = c[e]; cb[4 * h + e] = d[e]; } }
        float pg[8];
#pragma unroll
        for (int e = 0; e < 8; ++e) pg[e] = 0.f;
#pragma unroll
        for (int ai = 0; ai < 2; ++ai)
#pragma unroll
            for (int m = 0; m < 4; ++m) {
                const int row = rowb + ai * 64 + m * 16;
                const float s = 1.0f / sqrtf(ssq_x1[row] * (1.0f / D_MODEL) + EPS);
                float g[8], up[8], gm1[8], gm2[8];
#pragma unroll
                for (int e = 0; e < 8; ++e) { g[e] = (e < 4 ? acc[ai][0][m][0][e] : acc[ai][0][m][1][e - 4]) * s; up[e] = (e < 4 ? acc[ai][1][m][0][e] : acc[ai][1][m][1][e - 4]) * s; }
#pragma unroll
                for (int e = 0; e < 8; ++e) { const float c1 = dpp_ror1(g[e]), p1 = dpp_ror1(pg[e]), c2 = dpp_ror2(g[e]), p2 = dpp_ror2(pg[e]); gm1[e] = fr == 0 ? p1 : c1; gm2[e] = fr < 2 ? p2 : c2; }
                if (smp) {
                    const int j = fr & 3; const float* sb = sconv + (size_t)((row - R_SMP) >> 2) * 2 * FF + f0;
                    if (j < 2) { const f32x4 a = *(const f32x4*)(sb + FF), b = *(const f32x4*)(sb + FF + 4);
#pragma unroll
                        for (int e = 0; e < 8; ++e) { const float v = e < 4 ? a[e] : b[e - 4]; if (j == 0) gm1[e] = v; else gm2[e] = v; } }
                    if (j == 0) { const f32x4 a = *(const f32x4*)(sb), b = *(const f32x4*)(sb + 4);
#pragma unroll
                        for (int e = 0; e < 8; ++e) gm2[e] = e < 4 ? a[e] : b[e - 4]; }
                    if (j >= 2) { float* o = out + O_SC + ((size_t)((row - R_SMP) >> 2) * 2 + (j - 2)) * FF + f0; *(f32x4*)o = (f32x4){g[0], g[1], g[2], g[3]}; *(f32x4*)(o + 4) = (f32x4){g[4], g[5], g[6], g[7]}; }
                }
                const bool defer = !smp && ai == 0 && m == 0 && fr < 2;
                if (!mta && !defer) {
                    float hh[8];
#pragma unroll
                    for (int e = 0; e < 8; ++e) { const float c = cb[e] + w0[e] * gm2[e] + w1[e] * gm1[e] + w2[e] * g[e]; hh[e] = c / (1.0f + __builtin_amdgcn_exp2f(-LOG2E_F * c)) * up[e]; }
                    u32x4 w; w.x = cvt_pk_bf16(hh[0], hh[1]); w.y = cvt_pk_bf16(hh[2], hh[3]); w.z = cvt_pk_bf16(hh[4], hh[5]); w.w = cvt_pk_bf16(hh[6], hh[7]);
                    *(u32x4*)(HB + (size_t)row * FF + f0) = w;
                }
                if (!smp && !mta) {
                    if (ai == 0 && m == 0 && fr < 2) { float* o = cv0 + ((size_t)(u.pm * 4 + 2 * wr + fr) * 2) * FF + f0;
                        *(f32x4*)o = (f32x4){g[0], g[1], g[2], g[3]}; *(f32x4*)(o + 4) = (f32x4){g[4], g[5], g[6], g[7]}; *(f32x4*)(o + FF) = (f32x4){up[0], up[1], up[2], up[3]}; *(f32x4*)(o + FF + 4) = (f32x4){up[4], up[5], up[6], up[7]}; }
                    if (ai == 1 && m == 3 && fr >= 14) { float* o = cvg + (size_t)(u.pm * 4 + 2 * wr + (fr - 14)) * FF + f0; *(f32x4*)o = (f32x4){g[0], g[1], g[2], g[3]}; *(f32x4*)(o + 4) = (f32x4){g[4], g[5], g[6], g[7]};
                        if ((u.pm & 7) == 7 && wr == 1) { float* q = out + O_PC + ((size_t)(u.pm >> 3) * 2 + (fr - 14)) * FF + f0; *(f32x4*)q = (f32x4){g[0], g[1], g[2], g[3]}; *(f32x4*)(q + 4) = (f32x4){g[4], g[5], g[6], g[7]}; } }
                }
                if (mta && wr == 0 && ai == 0 && m == 0 && fr >= 14) { float* o = metag + (size_t)(fr - 14) * FF + f0; *(f32x4*)o = (f32x4){g[0], g[1], g[2], g[3]}; *(f32x4*)(o + 4) = (f32x4){g[4], g[5], g[6], g[7]}; }
#pragma unroll
                for (int e = 0; e < 8; ++e) pg[e] = g[e];
            }
    }
};
struct EpiDown {
    static constexpr bool PERM = true, AFTER_DRAIN = false, MID = false;
    unsigned char* ws; float* out;
    __device__ __forceinline__ void mid(f32x4 (&)[2][2][4][2], const Unit&, int, int, int, int) const {}
    __device__ __forceinline__ void operator()(const f32x4 (&acc)[2][2][4][2], const Unit& u, int wr, int wc, int fr, int fq) const {
        float* ssq_x2 = (float*)(ws + CTL_SSQ_X2);
        const int row0 = u.pm * BM + wr * 64 + fr, c0 = u.pn * BM + wc * 32 + 8 * fq;
#pragma unroll
        for (int ai = 0; ai < 2; ++ai)
#pragma unroll
            for (int m = 0; m < 4; ++m) {
                const int row = row0 + ai * HALF + m * 16;
                float* o = row < R_SMP ? out + O_YP + (size_t)row * D_MODEL : out + O_YS + (size_t)(row - R_SMP) * D_MODEL;
                float sq = 0.f;
#pragma unroll
                for (int bj = 0; bj < 2; ++bj) {
                    const int col = c0 + bj * HALF;
                    const f32x4 v0 = *(const f32x4*)(o + col) + acc[ai][bj][m][0], v1 = *(const f32x4*)(o + col + 4) + acc[ai][bj][m][1];
                    *(f32x4*)(o + col) = v0; *(f32x4*)(o + col + 4) = v1;
                    sq += (v0[0] * v0[0] + v0[1] * v0[1]) + (v0[2] * v0[2] + v0[3] * v0[3]) + (v1[0] * v1[0] + v1[1] * v1[1]) + (v1[2] * v1[2] + v1[3] * v1[3]);
                }
                sq = row_sum4(sq); if (fq == 0) atomicAdd(ssq_x2 + row, sq);
            }
    }
};
}
#define PH_P0 0
#define PH_P1 1
#define PH_P2 2
#define PH_P3 3
#define PH_P5 4
#define PH_P6 5
#define PH_P7 6
#define PH_P8 7
#define PH_END 8
__global__ void __launch_bounds__(NWAVES * 64, 2) mk_fwd(Params p) {
    extern __shared__ __attribute__((aligned(16))) unsigned char lds_raw[];
    LAS unsigned char* lds = (LAS unsigned char*)lds_raw;
    volatile LAS unsigned* MISC = (volatile LAS unsigned*)(lds + MISC_OFF);
    const int tid = threadIdx.x, lane = tid & 63, wave = __builtin_amdgcn_readfirstlane(tid >> 6);
    const int G = gridDim.x; const int bx = blockIdx.x; const int vcu = (G % 8 == 0) ? (bx % 8) * (G / 8) + bx / 8 : bx;
    gu32* ctl = (gu32*)(p.ws + WS_CTL);
    for (int u = tid; u < (LDS_BYTES - LDSCTL_OFF) / 4; u += NWAVES * 64) ((LAS unsigned*)(lds + LDSCTL_OFF))[u] = 0u;
    __syncthreads();
    (void)xcd_barrier_post((unsigned*)(ctl + CW_BAR), MISC + 8);
    const int lo = p.ph_lo, hi = p.ph_hi;
#define IN(k) (lo <= (k) && (k) < hi)
#define SEAM(k) do { if (IN(k) && IN((k) + 1)) { XcdBarrier b_; unsigned char* w_ = p.ws; asm volatile("" : "+s"(w_)); b_.bar = (unsigned*)(w_ + WS_CTL) + CW_BAR; b_.x = xb_xcc_id(); b_.st = (volatile LAS unsigned*)(lds + MISC_OFF) + 8; xcd_barrier(b_); } } while (0)

    if (IN(PH_P0)) { p0_prologue(p, lds, vcu, G, tid, wave, lane); }
    SEAM(PH_P0);
    if (IN(PH_P1)) {
        pg8::Gemm g{(const bf16*)(p.ws + WS_XN), (const bf16*)(p.ws + WS_WIN), MROWS, INC, D_MODEL, D_MODEL, 0, 0};
        pg8::StaticOrder S; S.init(MROWS, INC, G, bx);
        pg8::EpiProj E{p.ws, p.out};
        pg8::gemm_phase<pg8::EpiProj, pg8::StaticOrder, true, true>(lds + RING_OFF, g, S, E);
    }
    SEAM(PH_P1);
    if (IN(PH_P2)) { p2::p2_phase(p, lds, vcu, G, tid, wave, lane); }
    SEAM(PH_P2);
    if (IN(PH_P3)) {
        pg8::Gemm g{(const bf16*)(p.ws + WS_GG), (const bf16*)(p.ws + WS_WGLU), MROWS, SW, SW, 0, GS_BYTES, 0};
        pg8::StaticOrder S; S.init(MROWS, SW, G, bx);
        pg8::EpiGlu E{p.ws, p.in[I_BGLU]};
        pg8::gemm_phase<pg8::EpiGlu, pg8::StaticOrder, true, true>(lds + RING_OFF, g, S, E);
    }
    SEAM(PH_P3);
    if (IN(PH_P5)) {
        pg8::Gemm g{(const bf16*)(p.ws + WS_AO), (const bf16*)(p.ws + WS_WO), MROWS, D_MODEL, D_MODEL, D_MODEL, 0, 0};
        pg8::StaticOrder S; S.init(MROWS, D_MODEL, G, bx);
        pg8::EpiMix E{p.ws, p.out, p.in[I_XP], p.in[I_XS], p.in[I_META]};
        pg8::gemm_phase<pg8::EpiMix, pg8::StaticOrder, true, true>(lds + RING_OFF, g, S, E);
    }
    SEAM(PH_P5);
    if (IN(PH_P6)) {
        pg8::Gemm g{(const bf16*)(p.ws + WS_XN), (const bf16*)(p.ws + WS_WGU), MROWS, 2 * FF, D_MODEL, D_MODEL, 0, 1};
        pg8::StaticOrder S; S.init(MROWS, 2 * FF, G, bx);
        pg8::EpiGateUp E{p.ws, p.out, p.in[I_CONVW], p.in[I_CONVB], p.in[I_SCONV]};
        pg8::gemm_phase<pg8::EpiGateUp, pg8::StaticOrder, true, true>(lds + RING_OFF, g, S, E);
    }
    SEAM(PH_P6);
    if (IN(PH_P7)) {
        pg8::StaticOrder S; S.init(66 * 256, D_MODEL, G, bx);
        {
            const float* cvg = (const float*)(p.ws + WS_CVG); const float* cv0 = (const float*)(p.ws + WS_CV0); const float* mg = (const float*)(p.ws + WS_METAG); bf16* HB = (bf16*)(p.ws + WS_HB);
            pg8::Unit u;
            for (int i = 0; S.next(i, u); ++i) { if (u.pm >= 64) continue; const int pm = u.pm;
                for (int idx = tid; idx < 4 * FF; idx += NWAVES * 64) { const int q = idx / FF, f = idx % FF;
                    const float g0 = cv0[((size_t)(pm * 4 + q) * 2) * FF + f], up = cv0[((size_t)(pm * 4 + q) * 2 + 1) * FF + f]; float gm1, gm2;
                    const float* prev = (pm & 7) ? cvg + (size_t)((pm - 1) * 4 + 2) * FF : mg;
                    if (q == 0) { gm2 = prev[f]; gm1 = prev[FF + f]; } else if (q == 1) { gm2 = prev[FF + f]; gm1 = cv0[((size_t)(pm * 4 + 0) * 2) * FF + f]; }
                    else if (q == 2) { gm2 = cvg[(size_t)(pm * 4 + 0) * FF + f]; gm1 = cvg[(size_t)(pm * 4 + 1) * FF + f]; } else { gm2 = cvg[(size_t)(pm * 4 + 1) * FF + f]; gm1 = cv0[((size_t)(pm * 4 + 2) * 2) * FF + f]; }
                    const float c = p.in[I_CONVB][f] + p.in[I_CONVW][f] * gm2 + p.in[I_CONVW][FF + f] * gm1 + p.in[I_CONVW][2 * FF + f] * g0;
                    const float h = c / (1.0f + __builtin_amdgcn_exp2f(-1.4426950408889634f * c)) * up;
                    HB[(size_t)(pm * 256 + (q >> 1) * 128 + (q & 1)) * FF + f] = (bf16)f2bf(h); } }
            VM_WAIT(); __syncthreads();
        }
        pg8::Gemm g{(const bf16*)(p.ws + WS_HB), (const bf16*)(p.ws + WS_WD), 66 * 256, D_MODEL, FF, FF, 0, 0};
        pg8::EpiDown E{p.ws, p.out};
        pg8::gemm_phase<pg8::EpiDown, pg8::StaticOrder, true, true>(lds + RING_OFF, g, S, E);
    }
    SEAM(PH_P7);
    if (IN(PH_P8)) {
        const float* ssq = (const float*)(p.ws + CTL_SSQ_X2); const GAS f32x4* gf = (const GAS f32x4*)p.in[I_GFINAL] + lane;
        for (int m = vcu * NWAVES + wave; m < R_META; m += G * NWAVES) {
            const float rs = 1.0f / sqrtf(ssq[m] * (1.0f / D_MODEL) + EPS);
            GAS f32x4* o = (GAS f32x4*)(m < R_SMP ? p.out + O_YP + (size_t)m * D_MODEL : p.out + O_YS + (size_t)(m - R_SMP) * D_MODEL) + lane;
#pragma unroll
            for (int j = 0; j < 4; ++j) o[64 * j] = o[64 * j] * rs * gf[64 * j];
        }
    }
#undef IN
#undef SEAM
}
#if MK_DEBUG >= 0
namespace dbg {
__device__ __forceinline__ float bf2f(unsigned short b) { return __uint_as_float((unsigned)b << 16); }
__device__ __forceinline__ int fast_row(int c, int r) { return c < 8 ? (r < 16 ? R_META + r : c * 2048 + (r - 16)) : R_SMP + r; }
__global__ void k_bridge_proj(const unsigned char* ws, int c, int rows, float* proj) {
    const size_t i = (size_t)blockIdx.x * blockDim.x + threadIdx.x; if (i >= (size_t)rows * INC) return;
    const int r = (int)(i / INC), col = (int)(i % INC), fr = fast_row(c, r); float v;
    if (col < 512) v = bf2f(((const unsigned short*)(ws + WS_QB))[(size_t)fr * AW + col]) * (1.0f / QSCALE);
    else if (col < 640) v = bf2f(((const unsigned short*)(ws + WS_KB))[(size_t)fr * KVW + (col - 512)]);
    else if (col < 768) v = bf2f(((const unsigned short*)(ws + WS_VB))[(size_t)fr * KVW + (col - 640)]);
    else { const int uc = col - 768; v = bf2f(((const unsigned short*)(ws + WS_UG))[((size_t)(uc >> 4) * MROWS + fr) * 16 + (uc & 15)]); }
    proj[i] = v;
}
__global__ void k_bridge_ao(const unsigned char* ws, int c, int rows, int off, float* dst) {
    const size_t i = (size_t)blockIdx.x * blockDim.x + threadIdx.x; if (i >= (size_t)rows * 512) return;
    const int r = (int)(i / 512), col = (int)(i % 512), fr = fast_row(c, r);
    dst[i] = bf2f(((const unsigned short*)(ws + WS_AO))[(size_t)fr * D_MODEL + off + col]);
}
__global__ void k_bridge_gg(const unsigned char* ws, int c, int rows, float* dst) {
    const size_t i = (size_t)blockIdx.x * blockDim.x + threadIdx.x; if (i >= (size_t)rows * 512) return;
    const int r = (int)(i / 512), col = (int)(i % 512), fr = fast_row(c, r);
    dst[i] = bf2f(((const unsigned short*)(ws + WS_GG))[((size_t)(col >> 4) * MROWS + fr) * 16 + (col & 15)]);
}
__global__ void k_bridge_x1(const unsigned char* ws, const float* out, int c, int rows, float* dst) {
    const size_t i = (size_t)blockIdx.x * blockDim.x + threadIdx.x; if (i >= (size_t)rows * D_MODEL) return;
    const int r = (int)(i / D_MODEL), col = (int)(i % D_MODEL), fr = fast_row(c, r);
    dst[i] = fr < R_SMP ? out[O_YP + (size_t)fr * D_MODEL + col] : (fr < R_META ? out[O_YS + (size_t)(fr - R_SMP) * D_MODEL + col] : ((const float*)(ws + WS_X1M))[(size_t)(fr - R_META) * D_MODEL + col]);
}
__global__ void k_bridge_h(const unsigned char* ws, int c, int rows, float* dst) {
    const size_t i = (size_t)blockIdx.x * blockDim.x + threadIdx.x; if (i >= (size_t)rows * FF) return;
    const int r = (int)(i / FF), col = (int)(i % FF), fr = fast_row(c, r);
    dst[i] = bf2f(((const unsigned short*)(ws + WS_HB))[(size_t)fr * FF + col]);
}
}
#endif
static bool mk_setup(int& grid) {
    static int g = 0;
    if (g == 0) {
        int dev = 0, cus = 0, per_cu = 0;
        if (hipGetDevice(&dev) != hipSuccess || hipDeviceGetAttribute(&cus, hipDeviceAttributeMultiprocessorCount, dev) != hipSuccess) { fprintf(stderr, "kernel_launch: device query failed\n"); g = -1; return false; }
        if (hipFuncSetAttribute((const void*)mk_fwd, hipFuncAttributeMaxDynamicSharedMemorySize, LDS_BYTES) != hipSuccess) { fprintf(stderr, "kernel_launch: hipFuncSetAttribute failed\n"); g = -1; return false; }
        if (hipOccupancyMaxActiveBlocksPerMultiprocessor(&per_cu, (const void*)mk_fwd, NWAVES * 64, LDS_BYTES) != hipSuccess || per_cu < 1) fprintf(stderr, "kernel_launch: occupancy query reports %d\n", per_cu);
        (void)hipGetLastError();
        g = cus;
        if (g != 256) fprintf(stderr, "kernel_launch: %d CUs (built for 256)\n", g);
    }
    grid = g; return g > 0;
}
extern "C" void kernel_launch(void* const* d_in, const int* in_sizes, int n_in, void* d_out, int out_size, void* d_ws, size_t ws_size, hipStream_t stream) {
    (void)in_sizes; (void)n_in; (void)out_size;
#if MK_DEBUG == 0
    { rf::In I = rf::get_in(d_in); rf::Out O = rf::carve((float*)d_out); rf::Buf B = rf::carve_buf((unsigned char*)d_ws);
      for (int c = 0; c < 9; ++c) rf::chunk_forward(I, O, B, c, 0, false, false, stream); (void)ws_size; return; }
#else
    int grid = 0; if (!mk_setup(grid)) return;
    if (hipMemsetAsync((char*)d_ws + WS_CTL, 0, CTL_ZERO_BYTES, stream) != hipSuccess) { fprintf(stderr, "kernel_launch: memset failed\n"); return; }
    Params a{};
    for (int i = 0; i < 31; ++i) a.in[i] = (const float*)d_in[i];
    a.out = (float*)d_out; a.ws = (unsigned char*)d_ws;
#if MK_DEBUG < 0
    a.ph_lo = 0; a.ph_hi = PH_END;
#else
    constexpr int hi_of[8] = {0, PH_P1 + 1, PH_P2 + 1, PH_P2 + 1, PH_P3 + 1, PH_P5 + 1, PH_P6 + 1, PH_END};
    a.ph_lo = 0; a.ph_hi = hi_of[MK_DEBUG];
#endif
    hipLaunchKernelGGL(mk_fwd, dim3(grid), dim3(NWAVES * 64), LDS_BYTES, stream, a);
    { const hipError_t le = hipPeekAtLastError(); if (le != hipSuccess) fprintf(stderr, "kernel_launch: launch failed: %s\n", hipGetErrorName(le)); }
#if MK_DEBUG > 0 && MK_DEBUG < 7
    {
        static_assert(((WS_END + 4095) / 4096 * 4096) + rf::BUF_BYTES <= (size_t)256 * MiB, "debug build: oracle buffers do not fit behind the arena");
        unsigned char* ws = (unsigned char*)d_ws; (void)ws_size;
        rf::In I = rf::get_in(d_in); rf::Out O = rf::carve((float*)d_out); rf::Buf B = rf::carve_buf(ws + (WS_END + 4095) / 4096 * 4096);
        for (int c = 0; c < 9; ++c) {
            const int R = c < 8 ? rf::LP : rf::RS; int from = 0; bool have_att = false, have_g = false;
            auto nb = [](size_t n) { return (unsigned)((n + 255) / 256); };
            if (MK_DEBUG == 1 || MK_DEBUG == 2) { dbg::k_bridge_proj<<<nb((size_t)R * INC), 256, 0, stream>>>(ws, c, R, B.PROJ); from = 2; }
            if (MK_DEBUG == 2) { dbg::k_bridge_ao<<<nb((size_t)R * 512), 256, 0, stream>>>(ws, c, R, 0, B.ATT); have_att = true; }
            if (MK_DEBUG == 3) { dbg::k_bridge_ao<<<nb((size_t)R * 512), 256, 0, stream>>>(ws, c, R, 0, B.ATT); dbg::k_bridge_gg<<<nb((size_t)R * 512), 256, 0, stream>>>(ws, c, R, B.YS); from = 4; }
            if (MK_DEBUG == 4) { dbg::k_bridge_ao<<<nb((size_t)R * 512), 256, 0, stream>>>(ws, c, R, 0, B.ATT); dbg::k_bridge_ao<<<nb((size_t)R * 512), 256, 0, stream>>>(ws, c, R, 512, B.Z); from = 5; }
            if (MK_DEBUG == 5) { dbg::k_bridge_x1<<<nb((size_t)R * D_MODEL), 256, 0, stream>>>(ws, (const float*)d_out, c, R, B.X1); from = 6; }
            if (MK_DEBUG == 6) { dbg::k_bridge_x1<<<nb((size_t)R * D_MODEL), 256, 0, stream>>>(ws, (const float*)d_out, c, R, B.X1); dbg::k_bridge_h<<<nb((size_t)R * FF), 256, 0, stream>>>(ws, c, R, B.GT); from = 7; }
            rf::chunk_forward(I, O, B, c, from, have_att, have_g, stream);
        }
    }
#endif
#endif
}
```

```cpp
#include <hip/hip_runtime.h>
#include <cstdio>
#include <cstdint>
#include <cmath>
#define MK_DEBUG (-1)
#define MK_DUP (-1)
#define MK_DUP2 (0)
constexpr int D_MODEL = 1024, NBATCH = 8, SEQ = 2048, NMETA = 16, DBATCH = 128, DSEQ = 4, NHEAD = 8, NKVH = 2, HDIM = 64, WIN = 128;
constexpr int AW = 512, KVW = 128, SW = 512, INC = 1280, NG = 32, SG = 16, SP = 64, FF = 2816;
constexpr float EPS = 1e-5f;
constexpr int R_SMP = NBATCH * SEQ, R_META = R_SMP + DBATCH * DSEQ, R_END = R_META + NMETA, MROWS = 67 * 256;
constexpr float QSCALE = 0.125f * 1.4426950408889634f;
constexpr int TCH = 32, NCH = 65;

constexpr size_t KiB = 1024, MiB = 1u << 20;
constexpr size_t WS_CTL = 0, CTL_ZERO_BYTES = 1 * MiB;
constexpr int CW_TMO = 0, CW_CODE = 1, CW_BAR = 4096;
constexpr size_t CTL_SSQ_A = 64 * KiB, CTL_SSQ_S = CTL_SSQ_A + MROWS * 4, CTL_SSQ_X1 = CTL_SSQ_S + MROWS * 4, CTL_SSQ_X2 = CTL_SSQ_X1 + MROWS * 4;
constexpr size_t CTL_SSQ_DUMMY = CTL_SSQ_X2 + MROWS * 4;
static_assert(CTL_SSQ_DUMMY + MROWS * 4 <= CTL_ZERO_BYTES, "ctl");
constexpr size_t WS_WIN = 1 * MiB;
constexpr size_t WS_WGLU = WS_WIN + (size_t)INC * D_MODEL * 2;
constexpr size_t WS_WO = WS_WGLU + (size_t)SW * SW * 2;
constexpr size_t WS_WGU = WS_WO + (size_t)D_MODEL * D_MODEL * 2;
constexpr size_t WS_WD = WS_WGU + (size_t)2 * FF * D_MODEL * 2;
constexpr size_t WS_W1 = WS_WD + (size_t)D_MODEL * FF * 2;
constexpr size_t WS_W2 = WS_W1 + (size_t)NG * 128 * 512 * 2;
constexpr size_t WS_KC = WS_W2 + (size_t)NG * 512 * 128 * 2;
constexpr size_t WS_LAMT = WS_KC + (size_t)NG * 33 * 256 * 2;
constexpr size_t WS_LB = WS_LAMT + (size_t)NG * SP * 8;
constexpr size_t WS_BB = WS_LB + (size_t)NG * SP * 8;
constexpr size_t WS_XN = (WS_BB + (size_t)NG * SP * SG * 8 + 4095) / 4096 * 4096;
constexpr size_t WS_QB = WS_XN + (size_t)MROWS * D_MODEL * 2;
constexpr size_t WS_KB = WS_QB + (size_t)MROWS * AW * 2;
constexpr size_t WS_VB = WS_KB + (size_t)MROWS * KVW * 2;
constexpr size_t WS_UG = WS_VB + (size_t)MROWS * KVW * 2;
constexpr size_t WS_AO = WS_UG + (size_t)MROWS * SW * 2;
constexpr size_t WS_GG = WS_AO + (size_t)MROWS * D_MODEL * 2;
constexpr size_t WS_HB = WS_QB;
constexpr size_t WS_AFTER = WS_GG + (size_t)MROWS * SW * 2;
static_assert(WS_HB + (size_t)MROWS * FF * 2 <= WS_AFTER, "h overlay");
constexpr size_t WS_X1M = WS_AFTER;
constexpr size_t WS_END = WS_X1M + (size_t)256 * D_MODEL * 4;
constexpr size_t WS_CVG = WS_WIN;
constexpr size_t WS_METAG = WS_CVG + (size_t)67 * 4 * FF * 4;
constexpr size_t WS_CV0 = WS_W1;
static_assert(WS_METAG + 2 * FF * 4 <= WS_WGU && WS_CV0 + (size_t)67 * 8 * FF * 4 <= WS_XN, "side buffers over dead weights");
constexpr size_t GS_BYTES = (size_t)MROWS * 32;

constexpr int RING_OFF = 0, RING_BYTES = 131072;
constexpr int LDSCTL_OFF = 155648 - 512, MISC_OFF = LDSCTL_OFF + 320;
constexpr int LDS_BYTES = 155648;
constexpr int NWAVES = 8;
namespace pg8 {
#define PG8_LAS __attribute__((address_space(3)))
typedef unsigned short bf16_t;
typedef short bf16x8 __attribute__((ext_vector_type(8)));
typedef float f32x4 __attribute__((ext_vector_type(4)));
typedef float f32x2 __attribute__((ext_vector_type(2)));
typedef unsigned u32x4 __attribute__((ext_vector_type(4)));
typedef unsigned u32x2 __attribute__((ext_vector_type(2)));
constexpr int BM = 256, BK = 64, HALF = 128, HTB = HALF * BK * 2  , STAGE_BYTES = 8 * HTB, NXCD = 8, WGM = 8;

__host__ __device__ __forceinline__ int lds_byte(int r, int c) { const int st = (r >> 4) * 2 + (c >> 5), rr = r & 15, cc = c & 31, ob = rr * 64 + cc * 2; return st * 1024 + (ob ^ (((ob >> 9) & 1) << 5)); }
__host__ __device__ __forceinline__ void stage_rc(int b, int& R, int& C) { const int st = b / 1024, sb = b % 1024, swz = sb ^ (((sb >> 9) & 1) << 5); R = (st >> 1) * 16 + swz / 64; C = (st & 1) * 32 + (swz % 64) / 2; }
__host__ __device__ __forceinline__ int perm32(int rho) { const int n = rho >> 4, i = rho & 15; return 8 * (i >> 2) + 4 * n + (i & 3); }

struct Unit { int pm, pn; };
struct Gemm { const bf16_t* A; const bf16_t* Bt; int M, N, K, lda; size_t a_gs; int a_il; };

struct StaticOrder {
    int nM, nN, nwg, G, c;
    __host__ __device__ void init(int M, int N, int G_, int c_) { nM = M / BM; nN = N / BM; nwg = nM * nN; G = G_; c = c_; }
    __host__ __device__ bool next(int i, Unit& u) const {
        const long L = (long)i * G + c; if (L >= nwg) return false;
        int wgid = (int)L; { const int q = nwg / NXCD, r = nwg % NXCD, xcd = wgid % NXCD, off = wgid / NXCD; wgid = (xcd < r ? xcd * (q + 1) : r * (q + 1) + (xcd - r) * q) + off; }
        const int nig = WGM * nN, gid = wgid / nig, fm = gid * WGM, gsz = (nM - fm) < WGM ? (nM - fm) : WGM;
        u.pm = fm + ((wgid % nig) % gsz); u.pn = (wgid % nig) / gsz; return true;
    }
    __device__ __forceinline__ void a_ready(const Unit&) const {}
    __device__ __forceinline__ void done(const Unit&) const {}
};
__device__ __forceinline__ unsigned cvt_pk_bf16(float lo, float hi) { unsigned r; asm volatile("v_cvt_pk_bf16_f32 %0, %1, %2" : "=v"(r) : "v"(lo), "v"(hi)); return r; }
template <class Epi, class Sched, bool ALIGN_EPI = false, bool SP2 = false>
__device__ __forceinline__ void gemm_phase(PG8_LAS unsigned char* lds, const Gemm g, const Sched& S, const Epi& E) {
    const int tid = threadIdx.x, wid = __builtin_amdgcn_readfirstlane(tid >> 6), lane = tid & 63, wr = wid >> 2, wc = wid & 3, fr = lane & 15, fq = lane >> 4;
    const int K = g.K, nt = K / BK;
    unsigned voffA[2], voffB[2];
#pragma unroll
    for (int i = 0; i < 2; ++i) { int R, C; stage_rc(tid * 16 + i * 8192, R, C); const int Rb = Epi::PERM ? ((R & ~31) + perm32(R & 31)) : R;
        const int Ra = g.a_il ? ((R >> 6) * 128 + (R & 63)) : R;
        voffA[i] = g.a_gs ? (unsigned)((size_t)(C >> 4) * g.a_gs + (size_t)Ra * 32 + (C & 15) * 2) : (unsigned)(Ra * g.lda + C) * 2u; voffB[i] = (unsigned)(Rb * K + C) * 2u; }
    const size_t kstepA = g.a_gs ? 4 * g.a_gs : (size_t)(BK * 2), hstepA = (g.a_gs ? (size_t)32 : (size_t)g.lda * 2) * (g.a_il ? 64 : HALF), tstepA = (g.a_gs ? (size_t)32 : (size_t)g.lda * 2) * BM;
    const size_t kstepB = (size_t)(BK * 2), hstepB = (size_t)HALF * K * 2, tstepB = 2 * hstepB;
    const unsigned ldsw = (unsigned)wid * 1024u;
    const int aoff = lds_byte(wr * 64 + fr, fq * 8), boff = lds_byte(wc * 32 + fr, fq * 8);
#define PG8_SA(b, h) (((b) * 2 + (h)) * HTB)
#define PG8_SB(b, h) ((4 + (b) * 2 + (h)) * HTB)
#define PG8_STAGE(bufoff, gbase, voff) do { _Pragma("unroll") for (int _i = 0; _i < 2; ++_i) \
        __builtin_amdgcn_global_load_lds((const unsigned*)((const char*)(gbase) + (voff)[_i]), (PG8_LAS unsigned*)(lds + (bufoff) + ldsw + _i * 8192), 16, 0, 0); } while (0)
#define PG8_LDA(dst, b, h) do { _Pragma("unroll") for (int m = 0; m < 4; ++m) _Pragma("unroll") for (int k = 0; k < 2; ++k) dst[m][k] = *(const PG8_LAS bf16x8*)(lds + PG8_SA(b, h) + aoff + m * 2048 + k * 1024); } while (0)
#define PG8_LDB(dst, b, h) do { _Pragma("unroll") for (int n = 0; n < 2; ++n) _Pragma("unroll") for (int k = 0; k < 2; ++k) dst[n][k] = *(const PG8_LAS bf16x8*)(lds + PG8_SB(b, h) + boff + n * 2048 + k * 1024); } while (0)
#define PG8_MMA(ai, bj, At, Bt) do { __builtin_amdgcn_s_setprio(1); _Pragma("unroll") for (int m = 0; m < 4; ++m) _Pragma("unroll") for (int n = 0; n < 2; ++n) _Pragma("unroll") for (int k = 0; k < 2; ++k) \
        acc[ai][bj][m][n] = __builtin_amdgcn_mfma_f32_16x16x32_bf16(Bt[n][k], At[m][k], acc[ai][bj][m][n], 0, 0, 0); __builtin_amdgcn_s_setprio(0); } while (0)
#define PG8_WAIT_V(n) asm volatile("s_waitcnt vmcnt(" #n ")" ::: "memory")
#define PG8_WAIT_L(n) asm volatile("s_waitcnt lgkmcnt(" #n ")" ::: "memory")
#define PG8_BAR __builtin_amdgcn_s_barrier()
#define PG8_SCHED __builtin_amdgcn_sched_barrier(0)
    Unit cur, nxt; int ui = 0;
    if (!S.next(0, cur)) return;
    f32x4 acc[2][2][4][2];
#pragma unroll
    for (int a = 0; a < 2; ++a)
#pragma unroll
        for (int b = 0; b < 2; ++b)
#pragma unroll
            for (int m = 0; m < 4; ++m)
#pragma unroll
                for (int n = 0; n < 2; ++n) acc[a][b][m][n] = (f32x4){0.f, 0.f, 0.f, 0.f};
    bf16x8 At[4][2], B0[2][2], B1[2][2];
    const char* cA = (const char*)g.A + (size_t)cur.pm * tstepA; const char* cB = (const char*)g.Bt + (size_t)cur.pn * tstepB;
    S.a_ready(cur);
    if constexpr (SP2) {
        PG8_STAGE(PG8_SB(0, 0), cB, voffB); PG8_STAGE(PG8_SB(0, 1), cB + hstepB, voffB); PG8_STAGE(PG8_SA(0, 0), cA, voffA); PG8_STAGE(PG8_SA(0, 1), cA + hstepA, voffA);
        if (wr == 1) PG8_BAR;
        PG8_WAIT_V(2); PG8_BAR;
        PG8_STAGE(PG8_SB(1, 0), cB + kstepB, voffB); PG8_STAGE(PG8_SA(1, 0), cA + kstepA, voffA); PG8_STAGE(PG8_SB(1, 1), cB + hstepB + kstepB, voffB);
        PG8_WAIT_V(6); PG8_BAR;
    } else {
        PG8_STAGE(PG8_SB(0, 0), cB, voffB); PG8_STAGE(PG8_SA(0, 0), cA, voffA); PG8_STAGE(PG8_SB(0, 1), cB + hstepB, voffB); PG8_STAGE(PG8_SA(0, 1), cA + hstepA, voffA);
        if (wr == 1) PG8_BAR;
        PG8_WAIT_V(4); PG8_BAR;
        PG8_STAGE(PG8_SB(1, 0), cB + kstepB, voffB); PG8_STAGE(PG8_SA(1, 0), cA + kstepA, voffA); PG8_STAGE(PG8_SB(1, 1), cB + hstepB + kstepB, voffB);
        PG8_WAIT_V(6); PG8_BAR;
    }
    for (;;) {
        const bool has_next = S.next(ui + 1, nxt);
        const char* nA = has_next ? (const char*)g.A + (size_t)nxt.pm * tstepA : cA; const char* nB = has_next ? (const char*)g.Bt + (size_t)nxt.pn * tstepB : cB;
        for (int t = 0; t < nt; t += 2) {
            const bool last = (t == nt - 2);
            const char* a1 = cA + (size_t)(t + 1) * kstepA;
            const char* a2 = last ? nA : cA + (size_t)(t + 2) * kstepA; const char* b2 = last ? nB : cB + (size_t)(t + 2) * kstepB;
            const char* a3 = a2 + kstepA; const char* b3 = b2 + kstepB;
            if (last && has_next) S.a_ready(nxt);
            if constexpr (Epi::MID) { if (t == (nt >> 1)) E.mid(acc, cur, wr, wc, fr, fq); }
            if constexpr (SP2) {
            PG8_LDB(B0, 0, 0); PG8_LDB(B1, 0, 1); PG8_SCHED; PG8_LDA(At, 0, 0); PG8_STAGE(PG8_SA(1, 1), a1 + hstepA, voffA);
            PG8_WAIT_V(8); PG8_WAIT_L(0); PG8_BAR; PG8_MMA(0, 0, At, B0); PG8_MMA(0, 1, At, B1); PG8_BAR; PG8_SCHED;
            PG8_LDA(At, 0, 1); PG8_STAGE(PG8_SB(0, 0), b2, voffB); PG8_STAGE(PG8_SB(0, 1), b2 + hstepB, voffB); PG8_STAGE(PG8_SA(0, 0), a2, voffA);
            PG8_WAIT_V(8); PG8_WAIT_L(0); PG8_BAR; PG8_MMA(1, 0, At, B0); PG8_MMA(1, 1, At, B1); PG8_BAR; PG8_SCHED;
            PG8_LDB(B0, 1, 0); PG8_LDB(B1, 1, 1); PG8_SCHED; PG8_LDA(At, 1, 0); PG8_STAGE(PG8_SA(0, 1), a2 + hstepA, voffA);
            PG8_WAIT_V(8); PG8_WAIT_L(0); PG8_BAR; PG8_MMA(0, 0, At, B0); PG8_MMA(0, 1, At, B1); PG8_BAR; PG8_SCHED;
            PG8_LDA(At, 1, 1); PG8_STAGE(PG8_SB(1, 0), b3, voffB); PG8_STAGE(PG8_SB(1, 1), b3 + hstepB, voffB); PG8_STAGE(PG8_SA(1, 0), a3, voffA);
            PG8_WAIT_V(8); PG8_WAIT_L(0); PG8_BAR; PG8_MMA(1, 0, At, B0); PG8_MMA(1, 1, At, B1); PG8_BAR; PG8_SCHED;
            } else {
            PG8_LDB(B0, 0, 0); PG8_SCHED; PG8_LDA(At, 0, 0); PG8_STAGE(PG8_SA(1, 1), a1 + hstepA, voffA);
            PG8_WAIT_L(8); PG8_BAR; PG8_WAIT_L(0); PG8_MMA(0, 0, At, B0); PG8_BAR; PG8_SCHED;
            PG8_LDB(B1, 0, 1); PG8_STAGE(PG8_SB(0, 0), b2, voffB);
            PG8_BAR; PG8_WAIT_L(0); PG8_MMA(0, 1, At, B1); PG8_BAR;
            PG8_LDA(At, 0, 1); PG8_STAGE(PG8_SA(0, 0), a2, voffA);
            PG8_BAR; PG8_WAIT_L(0); PG8_MMA(1, 0, At, B0); PG8_BAR; PG8_SCHED;
            PG8_STAGE(PG8_SB(0, 1), b2 + hstepB, voffB);
            PG8_WAIT_V(6); PG8_BAR; PG8_MMA(1, 1, At, B1); PG8_BAR;
            PG8_LDB(B0, 1, 0); PG8_SCHED; PG8_LDA(At, 1, 0); PG8_STAGE(PG8_SA(0, 1), a2 + hstepA, voffA);
            PG8_WAIT_L(8); PG8_BAR; PG8_WAIT_L(0); PG8_MMA(0, 0, At, B0); PG8_BAR; PG8_SCHED;
            PG8_LDB(B1, 1, 1); PG8_STAGE(PG8_SB(1, 0), b3, voffB);
            PG8_BAR; PG8_WAIT_L(0); PG8_MMA(0, 1, At, B1); PG8_BAR;
            PG8_LDA(At, 1, 1); PG8_STAGE(PG8_SA(1, 0), a3, voffA);
            PG8_BAR; PG8_WAIT_L(0); PG8_MMA(1, 0, At, B0); PG8_BAR; PG8_SCHED;
            PG8_STAGE(PG8_SB(1, 1), b3 + hstepB, voffB);
            PG8_WAIT_V(6); PG8_BAR; PG8_MMA(1, 1, At, B1); PG8_BAR;
            }
        }
        if constexpr (ALIGN_EPI) { if (wr == 0) PG8_BAR; }
        if constexpr (!Epi::AFTER_DRAIN) { E(acc, cur, wr, wc, fr, fq); S.done(cur); }
        if (!has_next) break;
#pragma unroll
        for (int a = 0; a < 2; ++a)
#pragma unroll
            for (int b = 0; b < 2; ++b)
#pragma unroll
                for (int m = 0; m < 4; ++m)
#pragma unroll
                    for (int n = 0; n < 2; ++n) acc[a][b][m][n] = (f32x4){0.f, 0.f, 0.f, 0.f};
        cur = nxt; cA = nA; cB = nB; ++ui;
        if constexpr (ALIGN_EPI) { if (wr == 1) PG8_BAR; }
    }
    PG8_WAIT_V(0);
    if constexpr (!ALIGN_EPI) { if (wr == 0) PG8_BAR; }
    PG8_BAR;
    if constexpr (Epi::AFTER_DRAIN) { E.fused(acc, cur, wr, wc, fr, fq, lds, wid, lane); S.done(cur); }
#undef PG8_SA
#undef PG8_SB
#undef PG8_STAGE
#undef PG8_LDA
#undef PG8_LDB
#undef PG8_MMA
#undef PG8_WAIT_V
#undef PG8_WAIT_L
#undef PG8_BAR
#undef PG8_SCHED
}
}
#define GAS __attribute__((address_space(1)))
#define LAS __attribute__((address_space(3)))
typedef unsigned short bf16;
typedef unsigned v4u __attribute__((ext_vector_type(4)));
typedef float f32x4 __attribute__((ext_vector_type(4)));
typedef short bf16x8 __attribute__((ext_vector_type(8)));
typedef GAS unsigned gu32;
typedef GAS unsigned long long gu64;
#define RLX_AGENT __ATOMIC_RELAXED, __HIP_MEMORY_SCOPE_AGENT
#define LDS_WAIT() asm volatile("s_waitcnt lgkmcnt(0)" ::: "memory")
#define VM_WAIT() asm volatile("s_waitcnt vmcnt(0)" ::: "memory")
__device__ __forceinline__ unsigned long long rt() { return __builtin_amdgcn_s_memrealtime(); }
__device__ __forceinline__ unsigned f2bf(float f) { unsigned u = __builtin_bit_cast(unsigned, f); return (u + 0x7fffu + ((u >> 16) & 1u)) >> 16; }
__device__ __forceinline__ unsigned pk2(float lo, float hi) { return f2bf(lo) | (f2bf(hi) << 16); }

#define XB_TMO      128
#define XB_XCNT(j)  (256  + 64 * (j))
#define XB_XSUB(j)  (1280 + 64 * (j))
#define XB_XGEN(j)  (2304 + 64 * (j))
#define XB_TOP      3328
#define XB_TOPGEN   3392
#define XCD_BAR_WORDS 3456
#define XB_SPIN_CAP (1u << 18)

__device__ __forceinline__ unsigned xb_ld(unsigned* p)              { return __hip_atomic_load(p, __ATOMIC_RELAXED, __HIP_MEMORY_SCOPE_AGENT); }
__device__ __forceinline__ unsigned xb_add(unsigned* p, unsigned v) { return __hip_atomic_fetch_add(p, v, __ATOMIC_RELAXED, __HIP_MEMORY_SCOPE_AGENT); }
__device__ __forceinline__ unsigned xb_xcc_id() { return (unsigned)__builtin_amdgcn_s_getreg((3 << 11) | 20) & 0xFu; }
#define XB_SPIN(cond, bar) do { unsigned _sp = 0; while (cond) { __builtin_amdgcn_s_sleep(1); \
    if ((++_sp & 255u) == 0u) { if (xb_ld(&(bar)[XB_TMO])) break; if (_sp > XB_SPIN_CAP) { atomicAdd(&(bar)[XB_TMO], 1u); break; } } } } while (0)

struct XcdBarrier {
    unsigned* bar; unsigned x;
    volatile LAS unsigned* st;
};

__device__ __forceinline__ XcdBarrier xcd_barrier_post(unsigned* bar, volatile LAS unsigned* st) {
    XcdBarrier b; b.bar = bar; b.x = xb_xcc_id(); b.st = st;
    if (threadIdx.x == 0) (void)xb_add(&bar[XB_XCNT(b.x)], 1u);
    return b;
}
__device__ __forceinline__ void xcd_barrier_complete(unsigned* bar, unsigned x, unsigned& nloc, unsigned& nx) {
    const unsigned G = gridDim.x * gridDim.y * gridDim.z;
    unsigned sum, cnt, mine, sp = 0u;
    for (;;) {
        sum = 0u; cnt = 0u; mine = 0u;
#pragma unroll
        for (unsigned j = 0; j < 16; ++j) { const unsigned c = xb_ld(&bar[XB_XCNT(j)]); sum += c; cnt += (c > 0u) ? 1u : 0u; mine = (j == x) ? c : mine; }
        if (sum == G) break;
        __builtin_amdgcn_s_sleep(1);
        if ((++sp & 255u) == 0u) { if (xb_ld(&bar[XB_TMO])) break; if (sp > XB_SPIN_CAP) { atomicAdd(&bar[XB_TMO], 1u); break; } }
    }
    nloc = mine > 0u ? mine : 1u; nx = cnt > 0u ? cnt : 1u;
}

__device__ __forceinline__ void xcd_barrier(const XcdBarrier& b) {
    asm volatile("s_waitcnt vmcnt(0)" ::: "memory");
    __syncthreads();
    if (threadIdx.x == 0) {
        unsigned* bar = b.bar;
        __builtin_amdgcn_s_waitcnt(0);
        unsigned nloc = b.st[0], nx = b.st[1];
        if (nloc == 0u) { xcd_barrier_complete(bar, b.x, nloc, nx); b.st[0] = nloc; b.st[1] = nx; }
        const unsigned old = xb_add(&bar[XB_XSUB(b.x)], 1u);
        const unsigned gen = old / nloc;
        if (old + 1u == (gen + 1u) * nloc) {
            __builtin_amdgcn_fence(__ATOMIC_RELEASE, "agent");
            asm volatile("s_waitcnt vmcnt(0)" ::: "memory");
            const unsigned og = xb_add(&bar[XB_TOP], 1u);
            const unsigned tg = og / nx;
            if (og + 1u == (tg + 1u) * nx) xb_add(&bar[XB_TOPGEN], 1u);
            else XB_SPIN(xb_ld(&bar[XB_TOPGEN]) == tg, bar);
            __builtin_amdgcn_fence(__ATOMIC_ACQUIRE, "agent");
            xb_add(&bar[XB_XGEN(b.x)], 1u);
            asm volatile("s_waitcnt vmcnt(0)" ::: "memory");
        } else {
            XB_SPIN(xb_ld(&bar[XB_XGEN(b.x)]) == gen, bar);
            __builtin_amdgcn_fence(__ATOMIC_ACQUIRE, "agent");
            asm volatile("s_waitcnt vmcnt(0)" ::: "memory");
        }
    }
    __syncthreads();
}
struct Params { const float* in[31]; float* out; unsigned char* ws; int ph_lo, ph_hi; };
enum { I_XP = 0, I_XS, I_CK, I_CV, I_SRE, I_SIM, I_SCONV, I_META, I_GMIX, I_WIN, I_SINKS, I_LAMRE, I_LAMIM, I_LOGDT, I_BRE, I_BIM, I_CRE, I_CIM, I_DSKIP, I_WGLU, I_BGLU, I_GA, I_GS, I_WO, I_GFFN, I_WGATE, I_WUP, I_CONVW, I_CONVB, I_WDOWN, I_GFINAL };
constexpr size_t O_YP = 0, O_YS = O_YP + (size_t)NBATCH * SEQ * D_MODEL, O_PK = O_YS + (size_t)DBATCH * DSEQ * D_MODEL, O_PV = O_PK + NBATCH * WIN * KVW, O_PRE = O_PV + NBATCH * WIN * KVW,
                 O_PIM = O_PRE + NBATCH * NG * SP, O_PC = O_PIM + NBATCH * NG * SP, O_SK = O_PC + NBATCH * 2 * FF, O_SV = O_SK + (size_t)DBATCH * WIN * KVW, O_SRE = O_SV + (size_t)DBATCH * WIN * KVW,
                 O_SIM = O_SRE + DBATCH * NG * SP, O_SC = O_SIM + DBATCH * NG * SP, O_END = O_SC + (size_t)DBATCH * 2 * FF;
static_assert(O_END == 23080960, "output size");

__device__ __forceinline__ float wave_sum(float v) {
#pragma unroll
    for (int o = 1; o < 64; o <<= 1) v += __shfl_xor(v, o);
    return v;
}
__device__ __forceinline__ const float* x_src_row(const Params& p, int r) {
    return r < R_SMP ? p.in[I_XP] + (size_t)r * D_MODEL : (r < R_META ? p.in[I_XS] + (size_t)(r - R_SMP) * D_MODEL : p.in[I_META] + (size_t)(r - R_META) * D_MODEL);
}
__device__ __forceinline__ void p0_transpose_item(const float* W, int K, int N, bf16* WT, int drow0, int k0, int n0, const float* sc, LAS float* scr, int lane) {
#pragma unroll 8
    for (int i = 0; i < 32; ++i) { const int kk = 2 * i + (lane >> 5); float v = W[(size_t)(k0 + kk) * N + n0 + (lane & 31)]; if (sc) v *= sc[k0 + kk]; scr[kk * 33 + (lane & 31)] = v; }
    LDS_WAIT(); asm volatile("" ::: "memory");
    const int c = lane & 7;
#pragma unroll
    for (int j = 0; j < 4; ++j) { const int n = (lane >> 3) + 8 * j; const LAS float* s = scr + (8 * c) * 33 + n;
        v4u o; o.x = pk2(s[0 * 33], s[1 * 33]); o.y = pk2(s[2 * 33], s[3 * 33]); o.z = pk2(s[4 * 33], s[5 * 33]); o.w = pk2(s[6 * 33], s[7 * 33]);
        *(GAS v4u*)(WT + (size_t)(drow0 + n) * K + k0 + 8 * c) = o; }
    LDS_WAIT(); asm volatile("" ::: "memory");
}
__device__ __forceinline__ void rms_row_to_bf16(const float* xrow, bf16* orow, int lane) {
    const GAS f32x4* xr = (const GAS f32x4*)xrow + lane;
    f32x4 v[4]; float s = 0.f;
#pragma unroll
    for (int j = 0; j < 4; ++j) { v[j] = xr[64 * j]; s += (v[j].x * v[j].x + v[j].y * v[j].y) + (v[j].z * v[j].z + v[j].w * v[j].w); }
    const float rs = 1.f / sqrtf(wave_sum(s) * (1.f / D_MODEL) + EPS);
    GAS unsigned long long* o8 = (GAS unsigned long long*)orow + lane;
#pragma unroll
    for (int j = 0; j < 4; ++j) o8[64 * j] = (unsigned long long)pk2(v[j].x * rs, v[j].y * rs) | ((unsigned long long)pk2(v[j].z * rs, v[j].w * rs) << 32);
}
__device__ __forceinline__ double dexp(double x) {
    const double k = __builtin_rint(x * 1.4426950408889634074);
    double r = __builtin_fma(-k, 6.93147180369123816490e-01, x); r = __builtin_fma(-k, 1.90821492927058770002e-10, r);
    double p = 1.0 / 6227020800.0;
    p = __builtin_fma(p, r, 1.0 / 479001600.0); p = __builtin_fma(p, r, 1.0 / 39916800.0); p = __builtin_fma(p, r, 1.0 / 3628800.0); p = __builtin_fma(p, r, 1.0 / 362880.0); p = __builtin_fma(p, r, 1.0 / 40320.0);
    p = __builtin_fma(p, r, 1.0 / 5040.0); p = __builtin_fma(p, r, 1.0 / 720.0); p = __builtin_fma(p, r, 1.0 / 120.0); p = __builtin_fma(p, r, 1.0 / 24.0); p = __builtin_fma(p, r, 1.0 / 6.0); p = __builtin_fma(p, r, 0.5);
    p = __builtin_fma(p, r, 1.0); p = __builtin_fma(p, r, 1.0);
    return p * __longlong_as_double((long long)((int)k + 1023) << 52);
}
__device__ __forceinline__ void dsincos(double x, double& s, double& c) {
    const double k = __builtin_rint(x * 0.63661977236758134308);
    double r = __builtin_fma(-k, 1.57079632679489655800e+00, x); r = __builtin_fma(-k, 6.12323399573676603587e-17, r);
    const int q = (int)((long long)k) & 3; const double r2 = r * r;
    double sp = -1.0 / 1307674368000.0;
    sp = __builtin_fma(sp, r2, 1.0 / 6227020800.0); sp = __builtin_fma(sp, r2, -1.0 / 39916800.0); sp = __builtin_fma(sp, r2, 1.0 / 362880.0); sp = __builtin_fma(sp, r2, -1.0 / 5040.0); sp = __builtin_fma(sp, r2, 1.0 / 120.0); sp = __builtin_fma(sp, r2, -1.0 / 6.0);
    const double sn = __builtin_fma(r * r2, sp, r);
    double cp = 1.0 / 20922789888000.0;
    cp = __builtin_fma(cp, r2, -1.0 / 87178291200.0); cp = __builtin_fma(cp, r2, 1.0 / 479001600.0); cp = __builtin_fma(cp, r2, -1.0 / 3628800.0); cp = __builtin_fma(cp, r2, 1.0 / 40320.0); cp = __builtin_fma(cp, r2, -1.0 / 720.0); cp = __builtin_fma(cp, r2, 1.0 / 24.0); cp = __builtin_fma(cp, r2, -0.5);
    const double cs = __builtin_fma(cp, r2, 1.0);
    s = (q & 1) ? cs : sn; c = (q & 1) ? sn : cs; if (q == 1 || q == 2) c = -c; if (q >= 2) s = -s;
}
__device__ __forceinline__ void p0_ssm_tables(const Params& p, LAS unsigned char* lds, int task, int tid) {
    typedef float f2 __attribute__((ext_vector_type(2)));
    const int g = task >> 3, j = task & 7;
    LAS f2* PW = (LAS f2*)lds;
    LAS f2* BBl = PW + 12 * 64;
    LAS f2* CL = BBl + 64 * 16;
    const float* lam_re = p.in[I_LAMRE] + g * SP; const float* lam_im = p.in[I_LAMIM] + g * SP;
    const double dt = dexp((double)p.in[I_LOGDT][g]);
    for (int idx = tid; idx < 12 * 64; idx += 512) { const int e = idx >> 6, pp = idx & 63; const int ex = e < 4 ? 31 - 4 * j - e : (e < 8 ? 4 * j + 1 + (e - 4) : 4 * j + (e - 8));
        const double zr = (double)lam_re[pp] * dt * ex, zi = (double)lam_im[pp] * dt * ex, m = dexp(zr); double sn, cs; dsincos(zi, sn, cs); PW[idx] = (f2){(float)(m * cs), (float)(m * sn)}; }
    for (int idx = tid; idx < 1024; idx += 512) { const int pp = idx >> 4, c = idx & 15; const double lr = lam_re[pp], li = lam_im[pp], er = dexp(lr * dt); double sn, cs; dsincos(li * dt, sn, cs); const double lbr = er * cs, lbi = er * sn;
        const double nr = lbr - 1.0, ni = lbi, dn = lr * lr + li * li, fr = (nr * lr + ni * li) / dn, fi = (ni * lr - nr * li) / dn;
        const double br = p.in[I_BRE][(g * SP + pp) * SG + c], bi = p.in[I_BIM][(g * SP + pp) * SG + c]; BBl[idx] = (f2){(float)(fr * br - fi * bi), (float)(fr * bi + fi * br)}; }
    for (int idx = tid; idx < 1024; idx += 512) { CL[idx] = (f2){p.in[I_CRE][g * 1024 + idx], p.in[I_CIM][g * 1024 + idx]}; }
    __syncthreads();
    bf16* W1 = (bf16*)(p.ws + WS_W1) + (size_t)g * 128 * 512; bf16* W2 = (bf16*)(p.ws + WS_W2) + (size_t)g * 512 * 128; bf16* KC = (bf16*)(p.ws + WS_KC) + (size_t)g * 33 * 256;
    for (int idx = tid; idx < 4096; idx += 512) { const int s = idx >> 10, pp = (idx >> 4) & 63, ci = idx & 15; const f2 w = PW[s * 64 + pp], b = BBl[pp * 16 + ci];
        const int kk = (4 * j + s) * 16 + ci; W1[(size_t)pp * 512 + kk] = (bf16)f2bf(w.x * b.x - w.y * b.y); W1[(size_t)(64 + pp) * 512 + kk] = (bf16)f2bf(w.x * b.y + w.y * b.x); }
    for (int idx = tid; idx < 4096; idx += 512) { const int s = idx >> 10, co = (idx >> 6) & 15, pp = idx & 63; const f2 w = PW[(4 + s) * 64 + pp], c = CL[co * 64 + pp];
        const int n2 = (4 * j + s) * 16 + co; W2[(size_t)n2 * 128 + pp] = (bf16)f2bf(c.x * w.x - c.y * w.y); W2[(size_t)n2 * 128 + 64 + pp] = (bf16)f2bf(-(c.x * w.y + c.y * w.x)); }
    for (int idx = tid; idx < 1024; idx += 512) { const int s = idx >> 8, co = (idx >> 4) & 15, ci = idx & 15; float acc = 0.f;
#pragma unroll 4
        for (int pp = 0; pp < 64; ++pp) { const f2 w = PW[(8 + s) * 64 + pp], c = CL[co * 64 + pp], b = BBl[pp * 16 + ci]; const float cwr = c.x * w.x - c.y * w.y, cwi = c.x * w.y + c.y * w.x; acc += cwr * b.x - cwi * b.y; }
        KC[(size_t)((4 * j + s) + 1) * 256 + co * 16 + ci] = (bf16)f2bf(acc); }
    if (j == 0) {
        if (tid < 256) KC[tid] = 0;
        if (tid < 64) { const double zr = (double)lam_re[tid] * dt, zi = (double)lam_im[tid] * dt; const double m32 = dexp(32.0 * zr), m1 = dexp(zr); double s32, c32, s1, c1; dsincos(32.0 * zi, s32, c32); dsincos(zi, s1, c1);
            ((f2*)(p.ws + WS_LAMT))[g * SP + tid] = (f2){(float)(m32 * c32), (float)(m32 * s32)}; ((f2*)(p.ws + WS_LB))[g * SP + tid] = (f2){(float)(m1 * c1), (float)(m1 * s1)}; }
        for (int idx = tid; idx < 1024; idx += 512) ((f2*)(p.ws + WS_BB))[g * 1024 + idx] = BBl[idx];
    }
    __syncthreads();
}
__device__ __forceinline__ void p0_prologue(const Params& p, LAS unsigned char* lds, int vcu, int G, int tid, int wave, int lane) {
    for (int task = vcu; task < NG * 8; task += G) p0_ssm_tables(p, lds, task, tid);
    LAS float* scr = (LAS float*)(lds + RING_OFF + wave * 16384);
    const int gw = vcu * NWAVES + wave, NGW = G * NWAVES;
    bf16* WIN_T = (bf16*)(p.ws + WS_WIN); bf16* WGLU_T = (bf16*)(p.ws + WS_WGLU); bf16* WO_T = (bf16*)(p.ws + WS_WO); bf16* WGU_T = (bf16*)(p.ws + WS_WGU); bf16* WD_T = (bf16*)(p.ws + WS_WD);
    constexpr int I_A = 16 * 40, I_B = 8 * 16, I_C = 16 * 32, I_D = 16 * 88, I_E = 44 * 32;
    constexpr int NITEMS = I_A + I_B + I_C + 2 * I_D + I_E;
    for (int it = gw; it < NITEMS; it += NGW) {
        int r = it;
        if (r < I_A) { const int kb = r / 40, nb = r % 40; p0_transpose_item(p.in[I_WIN], 1024, INC, WIN_T, 32 * nb, 64 * kb, 32 * nb, p.in[I_GMIX], scr, lane); continue; } r -= I_A;
        if (r < I_B) { const int kb = r / 16, nb = r % 16; p0_transpose_item(p.in[I_WGLU], 512, 512, WGLU_T, 32 * nb, 64 * kb, 32 * nb, nullptr, scr, lane); continue; } r -= I_B;
        if (r < I_C) { const int kb = r / 32, nb = r % 32; p0_transpose_item(p.in[I_WO], 1024, 1024, WO_T, 32 * nb, 64 * kb, 32 * nb, kb < 8 ? p.in[I_GA] : p.in[I_GS] - 512, scr, lane); continue; } r -= I_C;
        if (r < I_D) { const int kb = r / 88, nb = r % 88, n0 = 32 * nb; p0_transpose_item(p.in[I_WGATE], 1024, FF, WGU_T, 256 * (n0 >> 7) + (n0 & 127), 64 * kb, n0, p.in[I_GFFN], scr, lane); continue; } r -= I_D;
        if (r < I_D) { const int kb = r / 88, nb = r % 88, n0 = 32 * nb; p0_transpose_item(p.in[I_WUP], 1024, FF, WGU_T, 256 * (n0 >> 7) + 128 + (n0 & 127), 64 * kb, n0, p.in[I_GFFN], scr, lane); continue; } r -= I_D;
        { const int kb = r / 32, nb = r % 32; p0_transpose_item(p.in[I_WDOWN], FF, 1024, WD_T, 32 * nb, 64 * kb, 32 * nb, nullptr, scr, lane); }
    }
    bf16* XN = (bf16*)(p.ws + WS_XN);
    for (int m = gw; m < MROWS; m += NGW) {
        if (m < R_END) rms_row_to_bf16(x_src_row(p, m), XN + (size_t)m * D_MODEL, lane);
        else { GAS unsigned long long* o8 = (GAS unsigned long long*)(XN + (size_t)m * D_MODEL) + lane;
#pragma unroll
            for (int j = 0; j < 4; ++j) o8[64 * j] = 0ull; }
    }
    { const int gt = vcu * (NWAVES * 64) + tid, NT = G * NWAVES * 64; constexpr int PER = (WIN - DSEQ) * KVW / 4;
        for (int i = gt; i < 2 * DBATCH * PER; i += NT) { const int kv = i / (DBATCH * PER), r = i % (DBATCH * PER), n = r / PER, q = r % PER;
            const f32x4 v = *((const GAS f32x4*)(p.in[kv ? I_CV : I_CK] + (size_t)n * WIN * KVW + DSEQ * KVW) + q);
            *((GAS f32x4*)(p.out + (kv ? O_SV : O_SK) + (size_t)n * WIN * KVW) + q) = v; } }
}
namespace p2 {
typedef float f32x16 __attribute__((ext_vector_type(16)));
typedef float f32x4 __attribute__((ext_vector_type(4)));
typedef short bf16x8 __attribute__((ext_vector_type(8)));
typedef short s16x4 __attribute__((ext_vector_type(4)));
typedef unsigned u32x4 __attribute__((ext_vector_type(4)));
constexpr float LOG2E = 1.4426950408889634f;
__device__ __forceinline__ int crow(int r, int hi) { return (r & 3) + 8 * (r >> 2) + 4 * hi; }
__device__ __forceinline__ unsigned cvtpk(float lo, float hi) { typedef float f2 __attribute__((ext_vector_type(2))); typedef __bf16 b2 __attribute__((ext_vector_type(2))); f2 v = {lo, hi}; b2 b = __builtin_convertvector(v, b2); return __builtin_bit_cast(unsigned, b); }
__device__ __forceinline__ float bf2f(unsigned short b) { return __uint_as_float((unsigned)b << 16); }
__device__ __forceinline__ s16x4 vtr(LAS const unsigned char* p) { typedef short v4i16_t __attribute__((ext_vector_type(4))); return __builtin_bit_cast(s16x4, __builtin_amdgcn_ds_read_tr16_b64_v4i16((LAS v4i16_t*)p)); }

constexpr int KS = 144, VS = 192;
template <class Mask>
__device__ __forceinline__ void attn_core(const bf16x8 (&qf)[4], LAS const unsigned char* Kl, LAS const unsigned char* Vl, float sink2, const Mask& mask, LAS float* wsf, LAS unsigned short* stg, int lane) {
    const int r32 = lane & 31, hi = lane >> 5;
    f32x16 sc[5];
#pragma unroll
    for (int j = 0; j < 5; ++j) {
        f32x16 a = {0.f, 0.f, 0.f, 0.f, 0.f, 0.f, 0.f, 0.f, 0.f, 0.f, 0.f, 0.f, 0.f, 0.f, 0.f, 0.f};
#pragma unroll
        for (int ks = 0; ks < 4; ++ks) { const bf16x8 kf = *(LAS const bf16x8*)(Kl + (j * 32 + r32) * KS + (16 * ks + 8 * hi) * 2); a = __builtin_amdgcn_mfma_f32_32x32x16_bf16(kf, qf[ks], a, 0, 0, 0); }
        sc[j] = a;
    }
    float m = sink2;
#pragma unroll
    for (int j = 0; j < 5; ++j)
#pragma unroll
        for (int r = 0; r < 16; ++r) { const float v = mask.valid(j * 32 + (r & 3) + 8 * (r >> 2)) ? sc[j][r] : -INFINITY; sc[j][r] = v; m = fmaxf(m, v); }
    m = fmaxf(m, __shfl_xor(m, 32));
    float l = 0.f;
#pragma unroll
    for (int j = 0; j < 5; ++j)
#pragma unroll
        for (int r = 0; r < 16; ++r) { const float e = __builtin_amdgcn_exp2f(sc[j][r] - m); sc[j][r] = e; l += e; }
    l += __shfl_xor(l, 32); l += __builtin_amdgcn_exp2f(sink2 - m);
    f32x16 o[2];
#pragma unroll
    for (int d = 0; d < 2; ++d) o[d] = (f32x16){0.f, 0.f, 0.f, 0.f, 0.f, 0.f, 0.f, 0.f, 0.f, 0.f, 0.f, 0.f, 0.f, 0.f, 0.f, 0.f};
    LAS const unsigned char* vbase = Vl + (4 * hi + ((lane & 15) >> 2)) * VS + (16 * ((lane >> 4) & 1) + 4 * (lane & 3)) * 2;
#pragma unroll
    for (int j = 0; j < 5; ++j)
#pragma unroll
        for (int s = 0; s < 2; ++s) {
            u32x4 pw; pw.x = cvtpk(sc[j][8 * s + 0], sc[j][8 * s + 1]); pw.y = cvtpk(sc[j][8 * s + 2], sc[j][8 * s + 3]); pw.z = cvtpk(sc[j][8 * s + 4], sc[j][8 * s + 5]); pw.w = cvtpk(sc[j][8 * s + 6], sc[j][8 * s + 7]);
            const bf16x8 pa = __builtin_bit_cast(bf16x8, pw);
#pragma unroll
            for (int d = 0; d < 2; ++d) {
                const s16x4 lo = vtr(vbase + (j * 32 + 16 * s) * VS + d * 64), hh = vtr(vbase + (j * 32 + 16 * s + 8) * VS + d * 64);
                const bf16x8 vf = {lo[0], lo[1], lo[2], lo[3], hh[0], hh[1], hh[2], hh[3]};
                o[d] = __builtin_amdgcn_mfma_f32_32x32x16_bf16(pa, vf, o[d], 0, 0, 0);
            }
        }
    if (hi == 0) wsf[r32] = 1.0f / l;
    asm volatile("s_waitcnt lgkmcnt(0)" ::: "memory");
#pragma unroll
    for (int r = 0; r < 16; ++r) { const int orow = crow(r, hi); const float rl = wsf[orow];
#pragma unroll
        for (int d = 0; d < 2; ++d) stg[orow * 64 + d * 32 + r32] = (unsigned short)(cvtpk(o[d][r] * rl, 0.f) & 0xffffu); }
    asm volatile("s_waitcnt lgkmcnt(0)" ::: "memory");
}
__device__ __forceinline__ void attn_store(LAS const unsigned short* stg, unsigned short* AO, float* ssq, int frow0, int col0, int rlo, int rhi, int lane) {
#pragma unroll
    for (int i = 0; i < 4; ++i) { const int row = i * 8 + (lane >> 3), ch = lane & 7; const u32x4 v = *(LAS const u32x4*)(stg + row * 64 + ch * 8);
        float s = 0.f;
#pragma unroll
        for (int e = 0; e < 4; ++e) { const float a = __uint_as_float(v[e] << 16), b = __uint_as_float(v[e] & 0xffff0000u); s += a * a + b * b; }
        s += __shfl_xor(s, 1); s += __shfl_xor(s, 2); s += __shfl_xor(s, 4);
        if (row >= rlo && row < rhi) { *(GAS u32x4*)(AO + (size_t)(frow0 + row) * D_MODEL + col0 + ch * 8) = v; if (ch == 0) atomicAdd(ssq + frow0 + row, s); } }
}
constexpr int AL_K = 0, AL_V = 256 * KS, AL_WS = AL_V + 256 * VS, AL_ST = AL_WS + NWAVES * 256, AL_END = AL_ST + NWAVES * 4096;
static_assert(AL_END <= RING_BYTES, "attention LDS");
struct PMask { int qq, sm2;
    __device__ __forceinline__ PMask(int r0, int smin, int lane) : qq((lane & 31) - 4 * (lane >> 5)), sm2(smin - r0 - 4 * (lane >> 5)) {}
    __device__ __forceinline__ bool valid(int K0) const { return K0 > qq && K0 <= qq + 128 && K0 >= sm2; } };
__device__ __forceinline__ void attn_prompt_unit(const Params& p, unsigned ssq_off, LAS unsigned char* lds, int qbase, int rmin, int kprev, int kcur, int smin, int kvh, int tid, int wave, int lane) {
    const unsigned short* KB = (const unsigned short*)(p.ws + WS_KB); const unsigned short* VB = (const unsigned short*)(p.ws + WS_VB); const unsigned short* QB = (const unsigned short*)(p.ws + WS_QB);
    unsigned short* AO = (unsigned short*)(p.ws + WS_AO); float* ssq = (float*)(p.ws + ssq_off);
#pragma unroll
    for (int it = 0; it < 4; ++it) { const int idx = it * 512 + tid, s = idx >> 3, ch = idx & 7; const int row = s < 128 ? kprev + s : kcur + (s - 128);
        u32x4 kv = {0u, 0u, 0u, 0u}, vv = {0u, 0u, 0u, 0u};
        if (s >= smin) { kv = *(const GAS u32x4*)(KB + (size_t)row * KVW + kvh * 64 + ch * 8); vv = *(const GAS u32x4*)(VB + (size_t)row * KVW + kvh * 64 + ch * 8); }
        *(LAS u32x4*)(lds + AL_K + s * KS + ch * 16) = kv; *(LAS u32x4*)(lds + AL_V + s * VS + ch * 16) = vv; }
    __syncthreads();
    const int g = wave >> 1, hf = wave & 1, h = kvh * 4 + g, r32 = lane & 31, hi = lane >> 5;
    const float sink2 = p.in[I_SINKS][h] * LOG2E;
    LAS float* wsf = (LAS float*)(lds + AL_WS + wave * 256); LAS unsigned short* stg = (LAS unsigned short*)(lds + AL_ST + wave * 4096);
    for (int qb = 0; qb < 2; ++qb) {
        const int r0 = hf * 64 + qb * 32;
        if (r0 + 32 <= rmin) continue;
        const int rq = (r0 + r32) >= rmin ? r0 + r32 : rmin;
        const unsigned short* qp = QB + (size_t)(qbase + rq) * AW + h * 64 + hi * 8;
        bf16x8 qf[4];
#pragma unroll
        for (int ks = 0; ks < 4; ++ks) qf[ks] = *(const GAS bf16x8*)(qp + ks * 16);
        const PMask mk(r0, smin, lane);
        attn_core(qf, lds + AL_K + r0 * KS, lds + AL_V + r0 * VS, sink2, mk, wsf, stg, lane);
        attn_store(stg, AO, ssq, qbase + r0, h * 64, rmin > r0 ? rmin - r0 : 0, 32, lane);
    }
    __syncthreads();
}
constexpr int SL_K = 0, SL_V = 2 * 160 * KS, SL_WS = SL_V + 2 * 160 * VS, SL_ST = SL_WS + NWAVES * 256, SL_END = SL_ST + NWAVES * 4096;
static_assert(SL_END <= LDSCTL_OFF, "sample attention LDS");
struct SMask { int tt;
    __device__ __forceinline__ explicit SMask(int lane) : tt((lane & 3) - 4 * (lane >> 5)) {}
    __device__ __forceinline__ bool valid(int K0) const { return K0 < 128 ? K0 > tt : (K0 - 128) <= tt; } };
__device__ __forceinline__ void attn_sample_unit(const Params& p, unsigned ssq_off, LAS unsigned char* lds, int n, int tid, int wave, int lane) {
    const unsigned short* KB = (const unsigned short*)(p.ws + WS_KB); const unsigned short* VB = (const unsigned short*)(p.ws + WS_VB); const unsigned short* QB = (const unsigned short*)(p.ws + WS_QB);
    unsigned short* AO = (unsigned short*)(p.ws + WS_AO); float* ssq = (float*)(p.ws + ssq_off);
    const float* ck = p.in[I_CK] + (size_t)n * WIN * KVW; const float* cv = p.in[I_CV] + (size_t)n * WIN * KVW;
    for (int idx = tid; idx < 2 * 160 * 8; idx += 512) { const int kvh = idx / 1280, rem = idx % 1280, s = rem >> 3, ch = rem & 7;
        u32x4 kv = {0u, 0u, 0u, 0u}, vv = {0u, 0u, 0u, 0u};
        if (s < 128) { const f32x4 a = *(const GAS f32x4*)(ck + (size_t)s * KVW + kvh * 64 + ch * 8), b = *(const GAS f32x4*)(ck + (size_t)s * KVW + kvh * 64 + ch * 8 + 4);
            const f32x4 c = *(const GAS f32x4*)(cv + (size_t)s * KVW + kvh * 64 + ch * 8), d = *(const GAS f32x4*)(cv + (size_t)s * KVW + kvh * 64 + ch * 8 + 4);
            kv = (u32x4){cvtpk(a[0], a[1]), cvtpk(a[2], a[3]), cvtpk(b[0], b[1]), cvtpk(b[2], b[3])}; vv = (u32x4){cvtpk(c[0], c[1]), cvtpk(c[2], c[3]), cvtpk(d[0], d[1]), cvtpk(d[2], d[3])}; }
        else if (s < 132) { const int row = R_SMP + 4 * n + (s - 128); kv = *(const GAS u32x4*)(KB + (size_t)row * KVW + kvh * 64 + ch * 8); vv = *(const GAS u32x4*)(VB + (size_t)row * KVW + kvh * 64 + ch * 8); }
        *(LAS u32x4*)(lds + SL_K + (kvh * 160 + s) * KS + ch * 16) = kv; *(LAS u32x4*)(lds + SL_V + (kvh * 160 + s) * VS + ch * 16) = vv; }
    __syncthreads();
    const int h = wave, kvh = h >> 2, r32 = lane & 31, hi = lane >> 5;
    const float sink2 = p.in[I_SINKS][h] * LOG2E;
    LAS float* wsf = (LAS float*)(lds + SL_WS + wave * 256); LAS unsigned short* stg = (LAS unsigned short*)(lds + SL_ST + wave * 4096);
    const unsigned short* qp = QB + (size_t)(R_SMP + 4 * n + (r32 & 3)) * AW + h * 64 + hi * 8;
    bf16x8 qf[4];
#pragma unroll
    for (int ks = 0; ks < 4; ++ks) qf[ks] = *(const GAS bf16x8*)(qp + ks * 16);
    const SMask mk(lane);
    attn_core(qf, lds + SL_K + kvh * 160 * KS, lds + SL_V + kvh * 160 * VS, sink2, mk, wsf, stg, lane);
    attn_store(stg, AO, ssq, R_SMP + 4 * n, h * 64, 0, 4, lane);
    __syncthreads();
}

constexpr int CS = 1056;
constexpr int SS_UL = 0, SS_S = 65 * CS, SS_H = SS_S + 65 * 128 * 4, SS_KC = SS_H + 80 * 272, SS_END = SS_KC + 33 * 512;
static_assert(SS_END <= LDSCTL_OFF && SS_S % 16 == 0 && SS_H % 16 == 0 && SS_KC % 16 == 0, "ssm LDS");
__device__ __forceinline__ float gelu_tanh(float y) { const float z = 0.7978845608028654f * (y + 0.044715f * y * y * y); return y / (1.0f + __builtin_amdgcn_exp2f(-2.0f * LOG2E * z)); }
__device__ __forceinline__ void ssm_item(const Params& p, LAS unsigned char* lds, int b, int g, int tid, int wave, int lane) {
    typedef float f2 __attribute__((ext_vector_type(2)));
    const unsigned short* UGg = (const unsigned short*)(p.ws + WS_UG) + (size_t)g * MROWS * 16; unsigned short* GGg = (unsigned short*)(p.ws + WS_GG) + (size_t)g * MROWS * 16;
    const unsigned short* W1 = (const unsigned short*)(p.ws + WS_W1) + (size_t)g * 128 * 512; const unsigned short* W2 = (const unsigned short*)(p.ws + WS_W2) + (size_t)g * 512 * 128;
    const unsigned short* KCg = (const unsigned short*)(p.ws + WS_KC) + (size_t)g * 33 * 256;
    for (int idx = tid; idx < 65 * 64; idx += 512) { const int j = idx >> 6, pc = idx & 63, sp = pc >> 1, half = pc & 1;
        int row = -1; if (j == 0) { if (sp >= 16) row = R_META + (sp - 16); } else row = b * SEQ + 32 * (j - 1) + sp;
        u32x4 v = {0u, 0u, 0u, 0u}; if (row >= 0) v = *(const GAS u32x4*)(UGg + (size_t)row * 16 + half * 8);
        *(LAS u32x4*)(lds + SS_UL + j * CS + sp * 32 + half * 16) = v; }
    for (int idx = tid; idx < 33 * 32; idx += 512) *(LAS u32x4*)(lds + SS_KC + idx * 16) = *(const GAS u32x4*)(KCg + idx * 8);
    __syncthreads();
    const int rr = lane & 15, kq = lane >> 4;
    LAS float* S = (LAS float*)(lds + SS_S); LAS unsigned short* Hb = (LAS unsigned short*)(lds + SS_H);
    int chb[5];
#pragma unroll
    for (int rb = 0; rb < 5; ++rb) { const int ch = 16 * rb + rr; chb[rb] = SS_UL + (ch > 64 ? 64 : ch) * CS + (kq >> 1) * 32 + (kq & 1) * 16; }
    {
        f32x4 acc[5];
#pragma unroll
        for (int rb = 0; rb < 5; ++rb) acc[rb] = (f32x4){0.f, 0.f, 0.f, 0.f};
        const unsigned short* w1p = W1 + (size_t)(16 * wave + rr) * 512 + 8 * kq;
#pragma unroll 4
        for (int ks = 0; ks < 16; ++ks) {
            const bf16x8 bfr = *(const GAS bf16x8*)(w1p + 32 * ks);
#pragma unroll
            for (int rb = 0; rb < 5; ++rb) { const bf16x8 afr = *(LAS const bf16x8*)(lds + chb[rb] + ks * 64); acc[rb] = __builtin_amdgcn_mfma_f32_16x16x32_bf16(afr, bfr, acc[rb], 0, 0, 0); }
        }
#pragma unroll
        for (int rb = 0; rb < 5; ++rb)
#pragma unroll
            for (int r = 0; r < 4; ++r) { const int j = 16 * rb + 4 * kq + r; if (j < 65) S[j * 128 + 16 * wave + rr] = acc[rb][r]; }
    }
    __syncthreads();
    if (tid < 64) {
        const f2 lt = ((const f2*)(p.ws + WS_LAMT))[g * SP + tid]; float hr = 0.f, hi = 0.f;
        for (int j = 0; j < 65; ++j) { Hb[j * 136 + tid] = (unsigned short)(cvtpk(hr, 0.f) & 0xffffu); Hb[j * 136 + 64 + tid] = (unsigned short)(cvtpk(hi, 0.f) & 0xffffu);
            const float sr = S[j * 128 + tid], si = S[j * 128 + 64 + tid]; const float nr = lt.x * hr - lt.y * hi + sr, ni = lt.x * hi + lt.y * hr + si; hr = nr; hi = ni; }
        p.out[O_PRE + ((size_t)b * NG + g) * SP + tid] = hr; p.out[O_PIM + ((size_t)b * NG + g) * SP + tid] = hi;
    }
    __syncthreads();
    {
        const int tq0 = wave, tq1 = 15 - wave, tq2 = 16 + wave, tq3 = 31 - wave;
        f32x4 acc[4][5];
#pragma unroll
        for (int q = 0; q < 4; ++q)
#pragma unroll
            for (int rb = 0; rb < 5; ++rb) acc[q][rb] = (f32x4){0.f, 0.f, 0.f, 0.f};
#define SSM_TOEP(q, tq) if (((tq) >> 1) >= ks) { const int t1 = (tq) - (2 * ks + (kq >> 1)) + 1; const bf16x8 bfr = *(LAS const bf16x8*)(lds + SS_KC + (t1 > 0 ? t1 : 0) * 512 + rr * 32 + (kq & 1) * 16); \
            _Pragma("unroll") for (int rb = 0; rb < 5; ++rb) acc[q][rb] = __builtin_amdgcn_mfma_f32_16x16x32_bf16(afr[rb], bfr, acc[q][rb], 0, 0, 0); }
        for (int ks = 0; ks < 16; ++ks) {
            bf16x8 afr[5];
#pragma unroll
            for (int rb = 0; rb < 5; ++rb) afr[rb] = *(LAS const bf16x8*)(lds + chb[rb] + ks * 64);
            SSM_TOEP(0, tq0) SSM_TOEP(1, tq1) SSM_TOEP(2, tq2) SSM_TOEP(3, tq3)
        }
#undef SSM_TOEP
#define SSM_INTER(q, tq) { const bf16x8 bfr = *(const GAS bf16x8*)(W2 + (size_t)((tq) * 16 + rr) * 128 + 32 * ks + 8 * kq); \
            _Pragma("unroll") for (int rb = 0; rb < 5; ++rb) acc[q][rb] = __builtin_amdgcn_mfma_f32_16x16x32_bf16(afr[rb], bfr, acc[q][rb], 0, 0, 0); }
#pragma unroll
        for (int ks = 0; ks < 4; ++ks) {
            bf16x8 afr[5];
#pragma unroll
            for (int rb = 0; rb < 5; ++rb) afr[rb] = *(LAS const bf16x8*)(lds + SS_H + (16 * rb + rr) * 272 + (32 * ks + 8 * kq) * 2);
            SSM_INTER(0, tq0) SSM_INTER(1, tq1) SSM_INTER(2, tq2) SSM_INTER(3, tq3)
        }
#undef SSM_INTER
        const float dsk = p.in[I_DSKIP][g * SG + rr];
asm volatile("s_waitcnt lgkmcnt(0)" ::: "memory"); __syncthreads();
#define SSM_EPI(q, tq) _Pragma("unroll") for (int rb = 0; rb < 5; ++rb) _Pragma("unroll") for (int r = 0; r < 4; ++r) { if (rb < 4 || (kq == 0 && r == 0)) { \
            LAS unsigned short* up = (LAS unsigned short*)(lds + SS_UL + (4 * kq) * CS + (tq) * 32 + rr * 2 + (16 * rb + r) * CS); const float y = acc[q][rb][r] + dsk * bf2f(*up); \
            *up = (unsigned short)(cvtpk(gelu_tanh(y), 0.f) & 0xffffu); } }
        SSM_EPI(0, tq0) SSM_EPI(1, tq1) SSM_EPI(2, tq2) SSM_EPI(3, tq3)
#undef SSM_EPI
    }
    asm volatile("s_waitcnt lgkmcnt(0)" ::: "memory"); __syncthreads();
    for (int idx = tid; idx < 65 * 64; idx += 512) { const int j = idx >> 6, pc = idx & 63, sp = pc >> 1, half = pc & 1;
        int row = -1; if (j == 0) { if (sp >= 16 && b == 0) row = R_META + (sp - 16); } else row = b * SEQ + 32 * (j - 1) + sp;
        if (row >= 0) *(GAS u32x4*)(GGg + (size_t)row * 16 + half * 8) = *(LAS const u32x4*)(lds + SS_UL + j * CS + sp * 32 + half * 16); }
    __syncthreads();
}
__device__ __forceinline__ void ssm_sample_task(const Params& p, LAS float* hs, int n, int g, int lane) {
    typedef float f2 __attribute__((ext_vector_type(2)));
    const unsigned short* UGg = (const unsigned short*)(p.ws + WS_UG) + (size_t)g * MROWS * 16; unsigned short* GGg = (unsigned short*)(p.ws + WS_GG) + (size_t)g * MROWS * 16;
    const f2 lb = ((const f2*)(p.ws + WS_LB))[g * SP + lane]; const f2* bb = (const f2*)(p.ws + WS_BB) + (size_t)(g * SP + lane) * SG;
    f2 bbr[SG];
#pragma unroll
    for (int c = 0; c < SG; ++c) bbr[c] = bb[c];
    float hr = p.in[I_SRE][((size_t)n * NG + g) * SP + lane], hi = p.in[I_SIM][((size_t)n * NG + g) * SP + lane];
#pragma unroll
    for (int t = 0; t < DSEQ; ++t) {
        const unsigned short* ur = UGg + (size_t)(R_SMP + 4 * n + t) * 16; float br = 0.f, bi = 0.f;
#pragma unroll
        for (int c = 0; c < SG; ++c) { const float uc = bf2f(ur[c]); br += bbr[c].x * uc; bi += bbr[c].y * uc; }
        const float nr = lb.x * hr - lb.y * hi + br, ni = lb.x * hi + lb.y * hr + bi; hr = nr; hi = ni;
        hs[(t * 64 + lane) * 2] = hr; hs[(t * 64 + lane) * 2 + 1] = hi;
    }
    p.out[O_SRE + ((size_t)n * NG + g) * SP + lane] = hr; p.out[O_SIM + ((size_t)n * NG + g) * SP + lane] = hi;
    asm volatile("s_waitcnt lgkmcnt(0)" ::: "memory");
    const int t = lane >> 4, co = lane & 15; const float* cr = p.in[I_CRE] + (size_t)(g * SG + co) * SP; const float* ci = p.in[I_CIM] + (size_t)(g * SG + co) * SP;
    float acc = 0.f;
#pragma unroll 8
    for (int pp = 0; pp < SP; ++pp) acc += cr[pp] * hs[(t * 64 + pp) * 2] - ci[pp] * hs[(t * 64 + pp) * 2 + 1];
    const size_t row = (size_t)(R_SMP + 4 * n + t);
    const float y = acc + p.in[I_DSKIP][g * SG + co] * bf2f(UGg[row * 16 + co]);
    GGg[row * 16 + co] = (unsigned short)(cvtpk(gelu_tanh(y), 0.f) & 0xffffu);
    asm volatile("s_waitcnt lgkmcnt(0)" ::: "memory");
}
__device__ __forceinline__ void p2_phase(const Params& p, unsigned ssq_off, LAS unsigned char* lds, int vcu, int G, int tid, int wave, int lane) {
#ifndef MK_DUP2
#define MK_DUP2 0
#endif
    for (int rep = 0; rep < (MK_DUP2 == 1 ? 2 : 1); ++rep) { const unsigned so = rep ? (unsigned)CTL_SSQ_DUMMY : ssq_off;
    for (int u = vcu; u < 258; u += G) {
        if (u < 256) { const int b = u >> 5, i = 1 + ((u >> 1) & 15), kvh = u & 1, qbase = b * SEQ + 128 * (i - 1);
            attn_prompt_unit(p, so, lds, qbase, 0, i == 1 ? R_META - 112 : qbase - 128, qbase, i == 1 ? 112 : 0, kvh, tid, wave, lane); }
        else attn_prompt_unit(p, so, lds, R_META - 112, 112, 0, R_META - 112, 240, u - 256, tid, wave, lane);
    } }
    for (int rep = 0; rep < (MK_DUP2 == 2 ? 2 : 1); ++rep) { const unsigned so = rep ? (unsigned)CTL_SSQ_DUMMY : ssq_off;
    for (int n = G - 1 - vcu; n < DBATCH; n += G) attn_sample_unit(p, so, lds, n, tid, wave, lane); }
    for (int rep = 0; rep < (MK_DUP2 == 3 ? 2 : 1); ++rep)
    for (int it = vcu; it < NBATCH * NG; it += G) ssm_item(p, lds, it >> 5, it & 31, tid, wave, lane);
    for (int rep = 0; rep < (MK_DUP2 == 4 ? 2 : 1); ++rep)
    for (int id = vcu * NWAVES + wave; id < DBATCH * NG; id += G * NWAVES) ssm_sample_task(p, (LAS float*)(lds + wave * 2048), id >> 5, id & 31, lane);
}
}
namespace pg8 {
struct EpiProj {
    static constexpr bool PERM = true, AFTER_DRAIN = false, MID = false;
    unsigned char* ws; float* out;
    __device__ __forceinline__ void mid(f32x4 (&)[2][2][4][2], const Unit&, int, int, int, int) const {}
    __device__ __forceinline__ void operator()(const f32x4 (&acc)[2][2][4][2], const Unit& u, int wr, int wc, int fr, int fq) const {
        bf16_t* QB = (bf16_t*)(ws + WS_QB); bf16_t* KB = (bf16_t*)(ws + WS_KB); bf16_t* VB = (bf16_t*)(ws + WS_VB); bf16_t* UG = (bf16_t*)(ws + WS_UG);
        const int row0 = u.pm * BM + wr * 64 + fr, c0 = wc * 32 + 8 * fq;
#pragma unroll
        for (int ai = 0; ai < 2; ++ai)
#pragma unroll
            for (int m = 0; m < 4; ++m) {
                const int row = row0 + ai * HALF + m * 16;
#pragma unroll
                for (int bj = 0; bj < 2; ++bj) {
                    const f32x4 v0 = acc[ai][bj][m][0], v1 = acc[ai][bj][m][1];
                    if (u.pn < 2) {
                        u32x4 w; w.x = cvt_pk_bf16(v0[0] * QSCALE, v0[1] * QSCALE); w.y = cvt_pk_bf16(v0[2] * QSCALE, v0[3] * QSCALE); w.z = cvt_pk_bf16(v1[0] * QSCALE, v1[1] * QSCALE); w.w = cvt_pk_bf16(v1[2] * QSCALE, v1[3] * QSCALE);
                        *(u32x4*)(QB + (size_t)row * AW + u.pn * 256 + bj * HALF + c0) = w;
                    } else if (u.pn == 2) {
                        u32x4 w; w.x = cvt_pk_bf16(v0[0], v0[1]); w.y = cvt_pk_bf16(v0[2], v0[3]); w.z = cvt_pk_bf16(v1[0], v1[1]); w.w = cvt_pk_bf16(v1[2], v1[3]);
                        *(u32x4*)((bj ? VB : KB) + (size_t)row * KVW + c0) = w;
                        float* o = nullptr;
                        if (row < R_SMP) { const int t = row & (SEQ - 1); if (t >= SEQ - WIN) o = out + (bj ? O_PV : O_PK) + ((size_t)(row >> 11) * WIN + (t - (SEQ - WIN))) * KVW + c0; }
                        else if (row < R_META) { const int rs = row - R_SMP; o = out + (bj ? O_SV : O_SK) + ((size_t)(rs >> 2) * WIN + (WIN - DSEQ) + (rs & 3)) * KVW + c0; }
                        if (o) { *(f32x4*)o = v0; *(f32x4*)(o + 4) = v1; }
                    } else {
                        const int uc = (u.pn - 3) * 256 + bj * HALF + c0;
                        u32x4 w; w.x = cvt_pk_bf16(v0[0], v0[1]); w.y = cvt_pk_bf16(v0[2], v0[3]); w.z = cvt_pk_bf16(v1[0], v1[1]); w.w = cvt_pk_bf16(v1[2], v1[3]);
                        *(u32x4*)(UG + ((size_t)(uc >> 4) * MROWS + row) * 16 + (uc & 15)) = w;
                    }
                }
            }
    }
};

__device__ __forceinline__ float row_sum4(float v) { v += __shfl_xor(v, 16); v += __shfl_xor(v, 32); return v; }
__device__ __forceinline__ float dpp_ror1(float v) { return __builtin_bit_cast(float, __builtin_amdgcn_update_dpp(0, __builtin_bit_cast(int, v), 0x121, 0xf, 0xf, false)); }
__device__ __forceinline__ float dpp_ror2(float v) { return __builtin_bit_cast(float, __builtin_amdgcn_update_dpp(0, __builtin_bit_cast(int, v), 0x122, 0xf, 0xf, false)); }
__device__ __forceinline__ float bf_lo(unsigned w) { return __uint_as_float(w << 16); }
__device__ __forceinline__ float bf_hi(unsigned w) { return __uint_as_float(w & 0xffff0000u); }
constexpr float LOG2E_F = 1.4426950408889634f;
struct EpiGlu {
    static constexpr bool PERM = true, AFTER_DRAIN = false, MID = false;
    unsigned char* ws; const float* b_glu; unsigned ssq_off;
    __device__ __forceinline__ void mid(f32x4 (&)[2][2][4][2], const Unit&, int, int, int, int) const {}
    __device__ __forceinline__ void operator()(const f32x4 (&acc)[2][2][4][2], const Unit& u, int wr, int wc, int fr, int fq) const {
        const bf16_t* GG = (const bf16_t*)(ws + WS_GG); bf16_t* AO = (bf16_t*)(ws + WS_AO); float* ssq_s = (float*)(ws + ssq_off);
        const int row0 = u.pm * BM + wr * 64 + fr, c0 = u.pn * BM + wc * 32 + 8 * fq;
        f32x4 bv[2][2];
#pragma unroll
        for (int bj = 0; bj < 2; ++bj)
#pragma unroll
            for (int n = 0; n < 2; ++n) bv[bj][n] = *(const f32x4*)(b_glu + c0 + bj * HALF + 4 * n);
#pragma unroll
        for (int ai = 0; ai < 2; ++ai)
#pragma unroll
            for (int m = 0; m < 4; ++m) {
                const int row = row0 + ai * HALF + m * 16; float ss = 0.f;
#pragma unroll
                for (int bj = 0; bj < 2; ++bj) {
                    const int col = c0 + bj * HALF;
                    const u32x4 gw = *(const u32x4*)(GG + ((size_t)(col >> 4) * MROWS + row) * 16 + (col & 15));
                    const f32x4 z0 = acc[ai][bj][m][0] + bv[bj][0], z1 = acc[ai][bj][m][1] + bv[bj][1];
                    float o[8]; const float gg[8] = {bf_lo(gw.x), bf_hi(gw.x), bf_lo(gw.y), bf_hi(gw.y), bf_lo(gw.z), bf_hi(gw.z), bf_lo(gw.w), bf_hi(gw.w)};
#pragma unroll
                    for (int e = 0; e < 8; ++e) { const float z = e < 4 ? z0[e] : z1[e - 4]; o[e] = gg[e] / (1.0f + __builtin_amdgcn_exp2f(-LOG2E_F * z)); ss += o[e] * o[e]; }
                    u32x4 w; w.x = cvt_pk_bf16(o[0], o[1]); w.y = cvt_pk_bf16(o[2], o[3]); w.z = cvt_pk_bf16(o[4], o[5]); w.w = cvt_pk_bf16(o[6], o[7]);
                    *(u32x4*)(AO + (size_t)row * D_MODEL + SW + col) = w;
                }
                ss = row_sum4(ss); if (fq == 0) atomicAdd(ssq_s + row, ss);
            }
    }
};
struct EpiMix {
    static constexpr bool PERM = true, AFTER_DRAIN = false, MID = true;
    unsigned char* ws; float* out; const float *xp, *xs, *meta; unsigned ssq_off;
    __device__ __forceinline__ void mid(f32x4 (&acc)[2][2][4][2], const Unit& u, int wr, int wc, int fr, int fq) const {
        const float* ssq_a = (const float*)(ws + CTL_SSQ_A); const float* ssq_s = (const float*)(ws + CTL_SSQ_S);
        int row0 = u.pm * BM + wr * 64 + fr; asm volatile("" : "+v"(row0));
#pragma unroll
        for (int ai = 0; ai < 2; ++ai)
#pragma unroll
            for (int m = 0; m < 4; ++m) { const int row = row0 + ai * HALF + m * 16;
                const float sa = 1.0f / sqrtf(ssq_a[row] * (1.0f / AW) + EPS), ss = 1.0f / sqrtf(ssq_s[row] * (1.0f / SW) + EPS), f = sa / ss;
#pragma unroll
                for (int bj = 0; bj < 2; ++bj)
#pragma unroll
                    for (int n = 0; n < 2; ++n) acc[ai][bj][m][n] *= f;
                asm volatile("" ::: "memory"); }
    }
    __device__ __forceinline__ void operator()(const f32x4 (&acc)[2][2][4][2], const Unit& u, int wr, int wc, int fr, int fq) const {
        const float* ssq_s = (const float*)(ws + CTL_SSQ_S); float* ssq_x1 = (float*)(ws + ssq_off); bf16_t* XG = (bf16_t*)(ws + WS_XN);
        const unsigned long long xa = (unsigned long long)xp, xb_ = (unsigned long long)xs, xc = (unsigned long long)meta, oa = (unsigned long long)(out + O_YP), obb = (unsigned long long)(out + O_YS), oc = (unsigned long long)(ws + WS_X1M);
        const float* xb = (const float*)(u.pm < 64 ? xa : (u.pm < 66 ? xb_ : xc)); float* ob = (float*)(u.pm < 64 ? oa : (u.pm < 66 ? obb : oc));
        const int rsub = u.pm < 64 ? 0 : (u.pm < 66 ? R_SMP : R_META), xrows = u.pm < 66 ? 0x7fffffff : NMETA;
        const int row0 = u.pm * BM + wr * 64 + fr, c0 = u.pn * BM + wc * 32 + 8 * fq;
#pragma unroll
        for (int ai = 0; ai < 2; ++ai)
#pragma unroll
            for (int m = 0; m < 4; ++m) {
                const int row = row0 + ai * HALF + m * 16, lr = row - rsub;
                const float ss = 1.0f / sqrtf(ssq_s[(unsigned)row] * (1.0f / SW) + EPS);
                float sq = 0.f;
#pragma unroll
                for (int bj = 0; bj < 2; ++bj) {
                    const unsigned off = (unsigned)(lr * D_MODEL + c0 + bj * HALF);
                    f32x4 x0 = {0.f, 0.f, 0.f, 0.f}, x1 = {0.f, 0.f, 0.f, 0.f};
                    if (lr < xrows) { x0 = *(const f32x4*)(xb + off); x1 = *(const f32x4*)(xb + off + 4); }
                    const f32x4 v0 = x0 + acc[ai][bj][m][0] * ss, v1 = x1 + acc[ai][bj][m][1] * ss;
                    *(f32x4*)(ob + off) = v0; *(f32x4*)(ob + off + 4) = v1;
                    u32x4 w; w.x = cvt_pk_bf16(v0[0], v0[1]); w.y = cvt_pk_bf16(v0[2], v0[3]); w.z = cvt_pk_bf16(v1[0], v1[1]); w.w = cvt_pk_bf16(v1[2], v1[3]);
                    *(u32x4*)(XG + (unsigned)(row * D_MODEL + c0 + bj * HALF)) = w;
                    sq += (v0[0] * v0[0] + v0[1] * v0[1]) + (v0[2] * v0[2] + v0[3] * v0[3]) + (v1[0] * v1[0] + v1[1] * v1[1]) + (v1[2] * v1[2] + v1[3] * v1[3]);
                }
                sq = row_sum4(sq); if (fq == 0) atomicAdd(ssq_x1 + (unsigned)row, sq);
                asm volatile("" ::: "memory");
            }
    }
};
struct EpiGateUp {
    static constexpr bool PERM = true, AFTER_DRAIN = false, MID = false;
    unsigned char* ws; float* out; const float *conv_w, *conv_b, *sconv;
    __device__ __forceinline__ void mid(f32x4 (&)[2][2][4][2], const Unit&, int, int, int, int) const {}
    __device__ __forceinline__ void operator()(const f32x4 (&acc)[2][2][4][2], const Unit& u, int wr, int wc, int fr, int fq) const {
        bf16_t* HB = (bf16_t*)(ws + WS_HB); const float* ssq_x1 = (const float*)(ws + CTL_SSQ_X1);
        float* cvg = (float*)(ws + WS_CVG); float* cv0 = (float*)(ws + WS_CV0); float* metag = (float*)(ws + WS_METAG);
        const int f0 = u.pn * HALF + wc * 32 + 8 * fq, rowb = u.pm * BM + wr * HALF + fr;
        const bool smp = (u.pm == 64 || u.pm == 65), mta = (u.pm == 66);
        float w0[8], w1[8], w2[8], cb[8];
#pragma unroll
        for (int h = 0; h < 2; ++h) { const f32x4 a = *(const f32x4*)(conv_w + f0 + 4 * h), b = *(const f32x4*)(conv_w + FF + f0 + 4 * h), c = *(const f32x4*)(conv_w + 2 * FF + f0 + 4 * h), d = *(const f32x4*)(conv_b + f0 + 4 * h);
#pragma unroll
            for (int e = 0; e < 4; ++e) { w0[4 * h + e] = a[e]; w1[4 * h + e] = b[e]; w2[4 * h + e] = c[e]; cb[4 * h + e] = d[e]; } }
        float pg[8];
#pragma unroll
        for (int e = 0; e < 8; ++e) pg[e] = 0.f;
#pragma unroll
        for (int ai = 0; ai < 2; ++ai)
#pragma unroll
            for (int m = 0; m < 4; ++m) {
                const int row = rowb + ai * 64 + m * 16;
                const float s = 1.0f / sqrtf(ssq_x1[row] * (1.0f / D_MODEL) + EPS);
                float g[8], up[8], gm1[8], gm2[8];
#pragma unroll
                for (int e = 0; e < 8; ++e) { g[e] = (e < 4 ? acc[ai][0][m][0][e] : acc[ai][0][m][1][e - 4]) * s; up[e] = (e < 4 ? acc[ai][1][m][0][e] : acc[ai][1][m][1][e - 4]) * s; }
#pragma unroll
                for (int e = 0; e < 8; ++e) { const float c1 = dpp_ror1(g[e]), p1 = dpp_ror1(pg[e]), c2 = dpp_ror2(g[e]), p2 = dpp_ror2(pg[e]); gm1[e] = fr == 0 ? p1 : c1; gm2[e] = fr < 2 ? p2 : c2; }
                if (smp) {
                    const int j = fr & 3; const float* sb = sconv + (size_t)((row - R_SMP) >> 2) * 2 * FF + f0;
                    if (j < 2) { const f32x4 a = *(const f32x4*)(sb + FF), b = *(const f32x4*)(sb + FF + 4);
#pragma unroll
                        for (int e = 0; e < 8; ++e) { const float v = e < 4 ? a[e] : b[e - 4]; if (j == 0) gm1[e] = v; else gm2[e] = v; } }
                    if (j == 0) { const f32x4 a = *(const f32x4*)(sb), b = *(const f32x4*)(sb + 4);
#pragma unroll
                        for (int e = 0; e < 8; ++e) gm2[e] = e < 4 ? a[e] : b[e - 4]; }
                    if (j >= 2) { float* o = out + O_SC + ((size_t)((row - R_SMP) >> 2) * 2 + (j - 2)) * FF + f0; *(f32x4*)o = (f32x4){g[0], g[1], g[2], g[3]}; *(f32x4*)(o + 4) = (f32x4){g[4], g[5], g[6], g[7]}; }
                }
                const bool defer = !smp && ai == 0 && m == 0 && fr < 2;
                if (!mta && !defer) {
                    float hh[8];
#pragma unroll
                    for (int e = 0; e < 8; ++e) { const float c = cb[e] + w0[e] * gm2[e] + w1[e] * gm1[e] + w2[e] * g[e]; hh[e] = c / (1.0f + __builtin_amdgcn_exp2f(-LOG2E_F * c)) * up[e]; }
                    u32x4 w; w.x = cvt_pk_bf16(hh[0], hh[1]); w.y = cvt_pk_bf16(hh[2], hh[3]); w.z = cvt_pk_bf16(hh[4], hh[5]); w.w = cvt_pk_bf16(hh[6], hh[7]);
                    *(u32x4*)(HB + (size_t)row * FF + f0) = w;
                }
                if (!smp && !mta) {
                    if (ai == 0 && m == 0 && fr < 2) { float* o = cv0 + ((size_t)(u.pm * 4 + 2 * wr + fr) * 2) * FF + f0;
                        *(f32x4*)o = (f32x4){g[0], g[1], g[2], g[3]}; *(f32x4*)(o + 4) = (f32x4){g[4], g[5], g[6], g[7]}; *(f32x4*)(o + FF) = (f32x4){up[0], up[1], up[2], up[3]}; *(f32x4*)(o + FF + 4) = (f32x4){up[4], up[5], up[6], up[7]}; }
                    if (ai == 1 && m == 3 && fr >= 14) { float* o = cvg + (size_t)(u.pm * 4 + 2 * wr + (fr - 14)) * FF + f0; *(f32x4*)o = (f32x4){g[0], g[1], g[2], g[3]}; *(f32x4*)(o + 4) = (f32x4){g[4], g[5], g[6], g[7]};
                        if ((u.pm & 7) == 7 && wr == 1) { float* q = out + O_PC + ((size_t)(u.pm >> 3) * 2 + (fr - 14)) * FF + f0; *(f32x4*)q = (f32x4){g[0], g[1], g[2], g[3]}; *(f32x4*)(q + 4) = (f32x4){g[4], g[5], g[6], g[7]}; } }
                }
                if (mta && wr == 0 && ai == 0 && m == 0 && fr >= 14) { float* o = metag + (size_t)(fr - 14) * FF + f0; *(f32x4*)o = (f32x4){g[0], g[1], g[2], g[3]}; *(f32x4*)(o + 4) = (f32x4){g[4], g[5], g[6], g[7]}; }
#pragma unroll
                for (int e = 0; e < 8; ++e) pg[e] = g[e];
            }
    }
};
struct EpiDown {
    static constexpr bool PERM = true, AFTER_DRAIN = false, MID = false;
    unsigned char* ws; float* out; unsigned ssq_off; int dry;
    __device__ __forceinline__ void mid(f32x4 (&)[2][2][4][2], const Unit&, int, int, int, int) const {}
    __device__ __forceinline__ void operator()(const f32x4 (&acc)[2][2][4][2], const Unit& u, int wr, int wc, int fr, int fq) const {
        float* ssq_x2 = (float*)(ws + ssq_off);
        const int row0 = u.pm * BM + wr * 64 + fr, c0 = u.pn * BM + wc * 32 + 8 * fq;
#pragma unroll
        for (int ai = 0; ai < 2; ++ai)
#pragma unroll
            for (int m = 0; m < 4; ++m) {
                const int row = row0 + ai * HALF + m * 16;
                float* o = row < R_SMP ? out + O_YP + (size_t)row * D_MODEL : out + O_YS + (size_t)(row - R_SMP) * D_MODEL;
                float sq = 0.f;
#pragma unroll
                for (int bj = 0; bj < 2; ++bj) {
                    const int col = c0 + bj * HALF;
                    const f32x4 v0 = *(const f32x4*)(o + col) + acc[ai][bj][m][0], v1 = *(const f32x4*)(o + col + 4) + acc[ai][bj][m][1];
                    if (!dry) { *(f32x4*)(o + col) = v0; *(f32x4*)(o + col + 4) = v1; }
                    sq += (v0[0] * v0[0] + v0[1] * v0[1]) + (v0[2] * v0[2] + v0[3] * v0[3]) + (v1[0] * v1[0] + v1[1] * v1[1]) + (v1[2] * v1[2] + v1[3] * v1[3]);
                }
                sq = row_sum4(sq); if (fq == 0) atomicAdd(ssq_x2 + row, sq);
            }
    }
};

template <int K, class Epi>
__device__ __forceinline__ void side_tile(const bf16_t* A, int lda, const bf16_t* Bt, PG8_LAS float* red, const Epi& E, int tid, int wave, int lane) {
    constexpr int KW = K / 8, NKS = KW / 32; static_assert(KW % 32 == 0, "side_tile K split");
    const int rr = lane & 15, kq = lane >> 4;
    f32x4 acc[2][4];
#pragma unroll
    for (int mb = 0; mb < 2; ++mb)
#pragma unroll
        for (int nb = 0; nb < 4; ++nb) acc[mb][nb] = (f32x4){0.f, 0.f, 0.f, 0.f};
    const bf16_t* ap = A + (size_t)rr * lda + wave * KW + 8 * kq; const bf16_t* bp = Bt + (size_t)rr * K + wave * KW + 8 * kq;
#pragma unroll 4
    for (int ks = 0; ks < NKS; ++ks) {
        bf16x8 a[2], b[4];
#pragma unroll
        for (int mb = 0; mb < 2; ++mb) a[mb] = *(const bf16x8*)(ap + (size_t)(mb * 16) * lda + 32 * ks);
#pragma unroll
        for (int nb = 0; nb < 4; ++nb) b[nb] = *(const bf16x8*)(bp + (size_t)(nb * 16) * K + 32 * ks);
#pragma unroll
        for (int mb = 0; mb < 2; ++mb)
#pragma unroll
            for (int nb = 0; nb < 4; ++nb) acc[mb][nb] = __builtin_amdgcn_mfma_f32_16x16x32_bf16(a[mb], b[nb], acc[mb][nb], 0, 0, 0);
    }
#pragma unroll
    for (int mb = 0; mb < 2; ++mb)
#pragma unroll
        for (int nb = 0; nb < 4; ++nb)
#pragma unroll
            for (int r = 0; r < 4; ++r) red[(wave * 32 + mb * 16 + 4 * kq + r) * 64 + nb * 16 + rr] = acc[mb][nb][r];
    asm volatile("s_waitcnt lgkmcnt(0)" ::: "memory"); __syncthreads();
    { const int row = tid >> 4, col = (tid & 15) * 4; f32x4 lo = {0.f, 0.f, 0.f, 0.f}, hi = {0.f, 0.f, 0.f, 0.f};
#pragma unroll
        for (int w = 0; w < 4; ++w) { lo += *(const PG8_LAS f32x4*)(red + (w * 32 + row) * 64 + col); hi += *(const PG8_LAS f32x4*)(red + ((w + 4) * 32 + row) * 64 + col); }
        E(row, col, lo, hi); }
    asm volatile("s_waitcnt lgkmcnt(0)" ::: "memory"); __syncthreads();
}
}
#ifndef MK_SIDE7DRY
#define MK_SIDE7DRY 0
#endif
#ifndef MK_SIDE5
#define MK_SIDE5 1
#endif
#ifndef MK_SIDE7
#define MK_SIDE7 1
#endif
#define PH_P0 0
#define PH_P1 1
#define PH_P2 2
#define PH_P3 3
#define PH_P5 4
#define PH_P6 5
#define PH_P7 6
#define PH_P8 7
#define PH_END 8
__global__ void __launch_bounds__(NWAVES * 64, 2) mk_fwd(Params p) {
    extern __shared__ __attribute__((aligned(16))) unsigned char lds_raw[];
    LAS unsigned char* lds = (LAS unsigned char*)lds_raw;
    volatile LAS unsigned* MISC = (volatile LAS unsigned*)(lds + MISC_OFF);
    const int tid = threadIdx.x, lane = tid & 63, wave = __builtin_amdgcn_readfirstlane(tid >> 6);
    const int G = gridDim.x; const int bx = blockIdx.x; const int vcu = (G % 8 == 0) ? (bx % 8) * (G / 8) + bx / 8 : bx;
    gu32* ctl = (gu32*)(p.ws + WS_CTL);
    for (int u = tid; u < (LDS_BYTES - LDSCTL_OFF) / 4; u += NWAVES * 64) ((LAS unsigned*)(lds + LDSCTL_OFF))[u] = 0u;
    __syncthreads();
    (void)xcd_barrier_post((unsigned*)(ctl + CW_BAR), MISC + 8);
    const int lo = p.ph_lo, hi = p.ph_hi;
#define IN(k) (lo <= (k) && (k) < hi)
#define SEAMF do { XcdBarrier b_; unsigned char* w_ = p.ws; asm volatile("" : "+s"(w_)); b_.bar = (unsigned*)(w_ + WS_CTL) + CW_BAR; b_.x = xb_xcc_id(); b_.st = (volatile LAS unsigned*)(lds + MISC_OFF) + 8; xcd_barrier(b_); } while (0)
#define SEAM(k) do { if (IN(k) && IN((k) + 1)) { XcdBarrier b_; unsigned char* w_ = p.ws; asm volatile("" : "+s"(w_)); b_.bar = (unsigned*)(w_ + WS_CTL) + CW_BAR; b_.x = xb_xcc_id(); b_.st = (volatile LAS unsigned*)(lds + MISC_OFF) + 8; xcd_barrier(b_); } } while (0)

    if (IN(PH_P0)) { for (int rep = 0; rep < (MK_DUP == PH_P0 ? 2 : 1); ++rep) { if (rep) SEAMF; p0_prologue(p, lds, vcu, G, tid, wave, lane); } }
    SEAM(PH_P0);
    if (IN(PH_P1)) {
      for (int rep = 0; rep < (MK_DUP == PH_P1 ? 2 : 1); ++rep) { if (rep) SEAMF;
        pg8::Gemm g{(const bf16*)(p.ws + WS_XN), (const bf16*)(p.ws + WS_WIN), MROWS, INC, D_MODEL, D_MODEL, 0, 0};
        pg8::StaticOrder S; S.init(MROWS, INC, G, bx);
        pg8::EpiProj E{p.ws, p.out};
        pg8::gemm_phase<pg8::EpiProj, pg8::StaticOrder, true, true>(lds + RING_OFF, g, S, E);
          }
    }
    SEAM(PH_P1);
    if (IN(PH_P2)) { for (int rep = 0; rep < (MK_DUP == PH_P2 ? 2 : 1); ++rep) { if (rep) SEAMF; p2::p2_phase(p, (unsigned)(rep ? CTL_SSQ_DUMMY : CTL_SSQ_A), lds, vcu, G, tid, wave, lane); } }
    SEAM(PH_P2);
    if (IN(PH_P3)) {
      for (int rep = 0; rep < (MK_DUP == PH_P3 ? 2 : 1); ++rep) { if (rep) SEAMF;
        pg8::Gemm g{(const bf16*)(p.ws + WS_GG), (const bf16*)(p.ws + WS_WGLU), MROWS, SW, SW, 0, GS_BYTES, 0};
        pg8::StaticOrder S; S.init(MROWS, SW, G, bx);
        pg8::EpiGlu E{p.ws, p.in[I_BGLU], (unsigned)(rep ? CTL_SSQ_DUMMY : CTL_SSQ_S)};
        pg8::gemm_phase<pg8::EpiGlu, pg8::StaticOrder, true, true>(lds + RING_OFF, g, S, E);
          }
    }
    SEAM(PH_P3);
    if (IN(PH_P5)) {
      for (int rep = 0; rep < (MK_DUP == PH_P5 ? 2 : 1); ++rep) { if (rep) SEAMF;
        pg8::Gemm g{(const bf16*)(p.ws + WS_AO), (const bf16*)(p.ws + WS_WO), MROWS, D_MODEL, D_MODEL, D_MODEL, 0, 0};
        pg8::StaticOrder S; S.init(MK_SIDE5 ? R_SMP : MROWS, D_MODEL, G, bx);
        pg8::EpiMix E{p.ws, p.out, p.in[I_XP], p.in[I_XS], p.in[I_META], (unsigned)(rep ? CTL_SSQ_DUMMY : CTL_SSQ_X1)};
        pg8::gemm_phase<pg8::EpiMix, pg8::StaticOrder, true, true>(lds + RING_OFF, g, S, E);
        for (int t = vcu; t < (MK_SIDE5 ? 272 : 0); t += G) {
            const int frow0 = t < 256 ? R_SMP + 32 * (t >> 4) : R_META, col0 = 64 * (t & 15);
            unsigned char* ws = p.ws; float* outp = p.out; const float* xsrc = t < 256 ? p.in[I_XS] + (size_t)(32 * (t >> 4)) * D_MODEL : p.in[I_META]; const int xrows = t < 256 ? 32 : NMETA;
            float* x1dst = t < 256 ? p.out + O_YS + (size_t)(32 * (t >> 4)) * D_MODEL : (float*)(p.ws + WS_X1M); const unsigned sso = (unsigned)(rep ? CTL_SSQ_DUMMY : CTL_SSQ_X1); (void)outp;
            auto epi = [=](int row, int col, pg8::f32x4 lo, pg8::f32x4 hi) {
                const int fr_ = frow0 + row; const float sa = 1.0f / sqrtf(((const float*)(ws + CTL_SSQ_A))[fr_] * (1.0f / AW) + EPS), ss = 1.0f / sqrtf(((const float*)(ws + CTL_SSQ_S))[fr_] * (1.0f / SW) + EPS);
                pg8::f32x4 x = {0.f, 0.f, 0.f, 0.f}; if (row < xrows) x = *(const pg8::f32x4*)(xsrc + (size_t)row * D_MODEL + col0 + col);
                const pg8::f32x4 v = x + lo * sa + hi * ss;
                *(pg8::f32x4*)(x1dst + (size_t)row * D_MODEL + col0 + col) = v;
                pg8::u32x2 w; w.x = pg8::cvt_pk_bf16(v[0], v[1]); w.y = pg8::cvt_pk_bf16(v[2], v[3]); *(pg8::u32x2*)((bf16*)(ws + WS_XN) + (size_t)fr_ * D_MODEL + col0 + col) = w;
                float sq = (v[0] * v[0] + v[1] * v[1]) + (v[2] * v[2] + v[3] * v[3]); sq += __shfl_xor(sq, 1); sq += __shfl_xor(sq, 2); sq += __shfl_xor(sq, 4); sq += __shfl_xor(sq, 8);
                if ((col & 63) == 0) atomicAdd((float*)(ws + sso) + fr_, sq); };
            pg8::side_tile<D_MODEL>((const bf16*)(p.ws + WS_AO) + (size_t)frow0 * D_MODEL, D_MODEL, (const bf16*)(p.ws + WS_WO) + (size_t)col0 * D_MODEL, (LAS float*)(lds + RING_OFF), epi, tid, wave, lane);
        }
          }
    }
    SEAM(PH_P5);
    if (IN(PH_P6)) {
      for (int rep = 0; rep < (MK_DUP == PH_P6 ? 2 : 1); ++rep) { if (rep) SEAMF;
        pg8::Gemm g{(const bf16*)(p.ws + WS_XN), (const bf16*)(p.ws + WS_WGU), MROWS, 2 * FF, D_MODEL, D_MODEL, 0, 1};
        pg8::StaticOrder S; S.init(MROWS, 2 * FF, G, bx);
        pg8::EpiGateUp E{p.ws, p.out, p.in[I_CONVW], p.in[I_CONVB], p.in[I_SCONV]};
        pg8::gemm_phase<pg8::EpiGateUp, pg8::StaticOrder, true, true>(lds + RING_OFF, g, S, E);
          }
    }
    SEAM(PH_P6);
    if (IN(PH_P7)) {
      for (int rep = 0; rep < (MK_DUP == PH_P7 ? 2 : 1); ++rep) { if (rep) SEAMF;
        pg8::StaticOrder S; S.init(MK_SIDE7 ? R_SMP : 66 * 256, D_MODEL, G, bx);
        {
            const float* cvg = (const float*)(p.ws + WS_CVG); const float* cv0 = (const float*)(p.ws + WS_CV0); const float* mg = (const float*)(p.ws + WS_METAG); bf16* HB = (bf16*)(p.ws + WS_HB);
            pg8::Unit u;
            for (int i = 0; S.next(i, u); ++i) { if (u.pm >= 64) continue; const int pm = u.pm;
                for (int idx = tid; idx < 4 * FF; idx += NWAVES * 64) { const int q = idx / FF, f = idx % FF;
                    const float g0 = cv0[((size_t)(pm * 4 + q) * 2) * FF + f], up = cv0[((size_t)(pm * 4 + q) * 2 + 1) * FF + f]; float gm1, gm2;
                    const float* prev = (pm & 7) ? cvg + (size_t)((pm - 1) * 4 + 2) * FF : mg;
                    if (q == 0) { gm2 = prev[f]; gm1 = prev[FF + f]; } else if (q == 1) { gm2 = prev[FF + f]; gm1 = cv0[((size_t)(pm * 4 + 0) * 2) * FF + f]; }
                    else if (q == 2) { gm2 = cvg[(size_t)(pm * 4 + 0) * FF + f]; gm1 = cvg[(size_t)(pm * 4 + 1) * FF + f]; } else { gm2 = cvg[(size_t)(pm * 4 + 1) * FF + f]; gm1 = cv0[((size_t)(pm * 4 + 2) * 2) * FF + f]; }
                    const float c = p.in[I_CONVB][f] + p.in[I_CONVW][f] * gm2 + p.in[I_CONVW][FF + f] * gm1 + p.in[I_CONVW][2 * FF + f] * g0;
                    const float h = c / (1.0f + __builtin_amdgcn_exp2f(-1.4426950408889634f * c)) * up;
                    HB[(size_t)(pm * 256 + (q >> 1) * 128 + (q & 1)) * FF + f] = (bf16)f2bf(h); } }
            VM_WAIT(); __syncthreads();
        }
        pg8::Gemm g{(const bf16*)(p.ws + WS_HB), (const bf16*)(p.ws + WS_WD), R_SMP, D_MODEL, FF, FF, 0, 0};
        pg8::EpiDown E{p.ws, p.out, (unsigned)((MK_DUP == PH_P7 && rep == 0) ? CTL_SSQ_DUMMY : CTL_SSQ_X2), (MK_DUP == PH_P7 && rep == 0) ? 1 : 0};
        pg8::gemm_phase<pg8::EpiDown, pg8::StaticOrder, true, true>(lds + RING_OFF, g, S, E);
        for (int t = vcu; t < ((MK_SIDE7 || MK_SIDE7DRY) ? 256 : 0); t += G) {
            const int frow0 = R_SMP + 32 * (t >> 4), col0 = 64 * (t & 15); unsigned char* ws = p.ws;
            float* xdst = p.out + O_YS + (size_t)(32 * (t >> 4)) * D_MODEL; const unsigned sso = MK_SIDE7DRY ? (unsigned)CTL_SSQ_DUMMY : E.ssq_off; const int dry = MK_SIDE7DRY ? 1 : E.dry;
            auto epi = [=](int row, int col, pg8::f32x4 lo, pg8::f32x4 hi) {
                float* o = xdst + (size_t)row * D_MODEL + col0 + col; const pg8::f32x4 v = *(const pg8::f32x4*)o + lo + hi;
                if (!dry) *(pg8::f32x4*)o = v;
                float sq = (v[0] * v[0] + v[1] * v[1]) + (v[2] * v[2] + v[3] * v[3]); sq += __shfl_xor(sq, 1); sq += __shfl_xor(sq, 2); sq += __shfl_xor(sq, 4); sq += __shfl_xor(sq, 8);
                if (col == 0) atomicAdd((float*)(ws + sso) + frow0 + row, sq); };
            pg8::side_tile<FF>((const bf16*)(p.ws + WS_HB) + (size_t)frow0 * FF, FF, (const bf16*)(p.ws + WS_WD) + (size_t)col0 * FF, (LAS float*)(lds + RING_OFF), epi, tid, wave, lane);
        }
          }
    }
    SEAM(PH_P7);
    if (IN(PH_P8)) {
        const float* ssq = (const float*)(p.ws + CTL_SSQ_X2); const GAS f32x4* gf = (const GAS f32x4*)p.in[I_GFINAL] + lane;
        for (int m = vcu * NWAVES + wave; m < R_META; m += G * NWAVES) {
            const float rs = 1.0f / sqrtf(ssq[m] * (1.0f / D_MODEL) + EPS);
            GAS f32x4* o = (GAS f32x4*)(m < R_SMP ? p.out + O_YP + (size_t)m * D_MODEL : p.out + O_YS + (size_t)(m - R_SMP) * D_MODEL) + lane;
#pragma unroll
            for (int j = 0; j < 4; ++j) o[64 * j] = o[64 * j] * rs * gf[64 * j];
        }
    }
#undef IN
#undef SEAM
}
#if MK_DEBUG >= 0
namespace dbg {
__device__ __forceinline__ float bf2f(unsigned short b) { return __uint_as_float((unsigned)b << 16); }
__device__ __forceinline__ int fast_row(int c, int r) { return c < 8 ? (r < 16 ? R_META + r : c * 2048 + (r - 16)) : R_SMP + r; }
__global__ void k_bridge_proj(const unsigned char* ws, int c, int rows, float* proj) {
    const size_t i = (size_t)blockIdx.x * blockDim.x + threadIdx.x; if (i >= (size_t)rows * INC) return;
    const int r = (int)(i / INC), col = (int)(i % INC), fr = fast_row(c, r); float v;
    if (col < 512) v = bf2f(((const unsigned short*)(ws + WS_QB))[(size_t)fr * AW + col]) * (1.0f / QSCALE);
    else if (col < 640) v = bf2f(((const unsigned short*)(ws + WS_KB))[(size_t)fr * KVW + (col - 512)]);
    else if (col < 768) v = bf2f(((const unsigned short*)(ws + WS_VB))[(size_t)fr * KVW + (col - 640)]);
    else { const int uc = col - 768; v = bf2f(((const unsigned short*)(ws + WS_UG))[((size_t)(uc >> 4) * MROWS + fr) * 16 + (uc & 15)]); }
    proj[i] = v;
}
__global__ void k_bridge_ao(const unsigned char* ws, int c, int rows, int off, float* dst) {
    const size_t i = (size_t)blockIdx.x * blockDim.x + threadIdx.x; if (i >= (size_t)rows * 512) return;
    const int r = (int)(i / 512), col = (int)(i % 512), fr = fast_row(c, r);
    dst[i] = bf2f(((const unsigned short*)(ws + WS_AO))[(size_t)fr * D_MODEL + off + col]);
}
__global__ void k_bridge_gg(const unsigned char* ws, int c, int rows, float* dst) {
    const size_t i = (size_t)blockIdx.x * blockDim.x + threadIdx.x; if (i >= (size_t)rows * 512) return;
    const int r = (int)(i / 512), col = (int)(i % 512), fr = fast_row(c, r);
    dst[i] = bf2f(((const unsigned short*)(ws + WS_GG))[((size_t)(col >> 4) * MROWS + fr) * 16 + (col & 15)]);
}
__global__ void k_bridge_x1(const unsigned char* ws, const float* out, int c, int rows, float* dst) {
    const size_t i = (size_t)blockIdx.x * blockDim.x + threadIdx.x; if (i >= (size_t)rows * D_MODEL) return;
    const int r = (int)(i / D_MODEL), col = (int)(i % D_MODEL), fr = fast_row(c, r);
    dst[i] = fr < R_SMP ? out[O_YP + (size_t)fr * D_MODEL + col] : (fr < R_META ? out[O_YS + (size_t)(fr - R_SMP) * D_MODEL + col] : ((const float*)(ws + WS_X1M))[(size_t)(fr - R_META) * D_MODEL + col]);
}
__global__ void k_bridge_h(const unsigned char* ws, int c, int rows, float* dst) {
    const size_t i = (size_t)blockIdx.x * blockDim.x + threadIdx.x; if (i >= (size_t)rows * FF) return;
    const int r = (int)(i / FF), col = (int)(i % FF), fr = fast_row(c, r);
    dst[i] = bf2f(((const unsigned short*)(ws + WS_HB))[(size_t)fr * FF + col]);
}
}
#endif
static bool mk_setup(int& grid) {
    static int g = 0;
    if (g == 0) {
        int dev = 0, cus = 0, per_cu = 0;
        if (hipGetDevice(&dev) != hipSuccess || hipDeviceGetAttribute(&cus, hipDeviceAttributeMultiprocessorCount, dev) != hipSuccess) { fprintf(stderr, "kernel_launch: device query failed\n"); g = -1; return false; }
        if (hipFuncSetAttribute((const void*)mk_fwd, hipFuncAttributeMaxDynamicSharedMemorySize, LDS_BYTES) != hipSuccess) { fprintf(stderr, "kernel_launch: hipFuncSetAttribute failed\n"); g = -1; return false; }
        if (hipOccupancyMaxActiveBlocksPerMultiprocessor(&per_cu, (const void*)mk_fwd, NWAVES * 64, LDS_BYTES) != hipSuccess || per_cu < 1) fprintf(stderr, "kernel_launch: occupancy query reports %d\n", per_cu);
        (void)hipGetLastError();
        g = cus;
        if (g != 256) fprintf(stderr, "kernel_launch: %d CUs (built for 256)\n", g);
    }
    grid = g; return g > 0;
}
extern "C" void kernel_launch(void* const* d_in, const int* in_sizes, int n_in, void* d_out, int out_size, void* d_ws, size_t ws_size, hipStream_t stream) {
    (void)in_sizes; (void)n_in; (void)out_size;
#if MK_DEBUG == 0
    { rf::In I = rf::get_in(d_in); rf::Out O = rf::carve((float*)d_out); rf::Buf B = rf::carve_buf((unsigned char*)d_ws);
      for (int c = 0; c < 9; ++c) rf::chunk_forward(I, O, B, c, 0, false, false, stream); (void)ws_size; return; }
#else
    int grid = 0; if (!mk_setup(grid)) return;
    if (hipMemsetAsync((char*)d_ws + WS_CTL, 0, CTL_ZERO_BYTES, stream) != hipSuccess) { fprintf(stderr, "kernel_launch: memset failed\n"); return; }
    Params a{};
    for (int i = 0; i < 31; ++i) a.in[i] = (const float*)d_in[i];
    a.out = (float*)d_out; a.ws = (unsigned char*)d_ws;
#if MK_DEBUG < 0
    a.ph_lo = 0; a.ph_hi = PH_END;
#else
    constexpr int hi_of[8] = {0, PH_P1 + 1, PH_P2 + 1, PH_P2 + 1, PH_P3 + 1, PH_P5 + 1, PH_P6 + 1, PH_END};
    a.ph_lo = 0; a.ph_hi = hi_of[MK_DEBUG];
#endif
    hipLaunchKernelGGL(mk_fwd, dim3(grid), dim3(NWAVES * 64), LDS_BYTES, stream, a);
    { const hipError_t le = hipPeekAtLastError(); if (le != hipSuccess) fprintf(stderr, "kernel_launch: launch failed: %s\n", hipGetErrorName(le)); }
#if MK_DEBUG > 0 && MK_DEBUG < 7
    {
        static_assert(((WS_END + 4095) / 4096 * 4096) + rf::BUF_BYTES <= (size_t)256 * MiB, "debug build: oracle buffers do not fit behind the arena");
        unsigned char* ws = (unsigned char*)d_ws; (void)ws_size;
        rf::In I = rf::get_in(d_in); rf::Out O = rf::carve((float*)d_out); rf::Buf B = rf::carve_buf(ws + (WS_END + 4095) / 4096 * 4096);
        for (int c = 0; c < 9; ++c) {
            const int R = c < 8 ? rf::LP : rf::RS; int from = 0; bool have_att = false, have_g = false;
            auto nb = [](size_t n) { return (unsigned)((n + 255) / 256); };
            if (MK_DEBUG == 1 || MK_DEBUG == 2) { dbg::k_bridge_proj<<<nb((size_t)R * INC), 256, 0, stream>>>(ws, c, R, B.PROJ); from = 2; }
            if (MK_DEBUG == 2) { dbg::k_bridge_ao<<<nb((size_t)R * 512), 256, 0, stream>>>(ws, c, R, 0, B.ATT); have_att = true; }
            if (MK_DEBUG == 3) { dbg::k_bridge_ao<<<nb((size_t)R * 512), 256, 0, stream>>>(ws, c, R, 0, B.ATT); dbg::k_bridge_gg<<<nb((size_t)R * 512), 256, 0, stream>>>(ws, c, R, B.YS); from = 4; }
            if (MK_DEBUG == 4) { dbg::k_bridge_ao<<<nb((size_t)R * 512), 256, 0, stream>>>(ws, c, R, 0, B.ATT); dbg::k_bridge_ao<<<nb((size_t)R * 512), 256, 0, stream>>>(ws, c, R, 512, B.Z); from = 5; }
            if (MK_DEBUG == 5) { dbg::k_bridge_x1<<<nb((size_t)R * D_MODEL), 256, 0, stream>>>(ws, (const float*)d_out, c, R, B.X1); from = 6; }
            if (MK_DEBUG == 6) { dbg::k_bridge_x1<<<nb((size_t)R * D_MODEL), 256, 0, stream>>>(ws, (const float*)d_out, c, R, B.X1); dbg::k_bridge_h<<<nb((size_t)R * FF), 256, 0, stream>>>(ws, c, R, B.GT); from = 7; }
            rf::chunk_forward(I, O, B, c, from, have_att, have_g, stream);
        }
    }
#endif
#endif
}
```
